# Optimizing an MI355X kernel written in HIP

```python
import math
import jax, jax.numpy as jnp
from jax import lax
import numpy as np

D_MODEL = 2048
BATCH = 16
SEQ = 2048
DEPTH = 2

GRID_W = 64
CTX_LEN = 256
N_BRANCH = 3
W_HY = 768
HY_ORDER = 2
HY_BANDS = 16
HY_FEAT = 1 + 2 * HY_BANDS
HY_HIDDEN = 64
HY_DECAY_MIN = -math.log(1e-2) / 1.5
HY_DECAY_MAX = -math.log(1e-2) / 0.3
W_ML = 768
ML_HEADS = 4
ML_DH = W_ML // ML_HEADS
ML_CHUNK = 64
W_S5 = 768
S5_GROUP = 16
S5_GROUPS = W_S5 // S5_GROUP
S5_STATE = 64
D_FF = 4 * D_MODEL
SPLIT_SIZES = ((HY_ORDER + 1) * W_HY, 2 * W_ML, W_ML, W_ML, 4 * ML_HEADS, W_S5, N_BRANCH * D_MODEL)
SPLIT_POINTS = tuple(int(v) for v in np.cumsum(SPLIT_SIZES)[:-1])
N_IN = int(sum(SPLIT_SIZES))
DEEPNORM_ALPHA = (2 * DEPTH) ** 0.25
DEEPNORM_BETA = (8 * DEPTH) ** -0.25
LN_EPS = 1e-5
F32 = jnp.float32

kernel_name = 'hybrid_hyena_mlstm_s5_diffusion_block'


def layer_norm(x, g, b):
    xf = x.astype(F32)
    mu = jnp.mean(xf, axis=-1, keepdims=True)
    var = jnp.mean(jnp.square(xf - mu), axis=-1, keepdims=True)
    y = (xf - mu) * lax.rsqrt(var + LN_EPS)
    return (y * g.astype(F32) + b.astype(F32)).astype(x.dtype)


def modulate(h, shift, scale):
    return h * (1 + scale) + shift


def short_conv(x, w, b, rows):
    B, L, C = x.shape
    xp = jnp.pad(x.reshape(B, rows, L // rows, C), ((0, 0), (0, 0), (1, 1), (0, 0)))
    y = xp[:, :, :-2] * w[0] + xp[:, :, 1:-1] * w[1] + xp[:, :, 2:] * w[2] + b
    return y.reshape(B, L, C)


def hyena_filters(L, w1, b1, w2, b2, w3, freq, decay):
    pos = jnp.arange(L, dtype=F32)
    t = pos / (L - 1)
    bands = jnp.linspace(1e-4, HY_BANDS - 1, HY_BANDS, dtype=F32)
    ang = (2.0 * math.pi / L) * pos[:, None] * bands[None, :]
    feats = jnp.concatenate([t[:, None], jnp.cos(ang), jnp.sin(ang)], axis=-1)
    freq = freq.astype(F32)
    h = jnp.sin(freq * (feats @ w1.astype(F32) + b1.astype(F32)))
    h = jnp.sin(freq * (h @ w2.astype(F32) + b2.astype(F32)))
    h = (h @ w3.astype(F32)).reshape(L, HY_ORDER, 2, W_HY)
    window = jnp.exp(-t[:, None, None] * jnp.abs(decay.astype(F32))[None])
    h = h * window[:, :, None, :]
    k_circ = jnp.concatenate([h[:, :, 0], jnp.zeros((1, HY_ORDER, W_HY), F32), h[:0:-1, :, 1]], axis=0)
    return jnp.fft.rfft(k_circ, axis=0)


def fft_long_conv(u, k_freq, bias):
    L = u.shape[1]
    y = jnp.fft.irfft(jnp.fft.rfft(u, n=2 * L, axis=1) * k_freq, n=2 * L, axis=1)[:, :L]
    return y + u * bias


def hyena_branch(z, rows, conv_w, conv_b, w1, b1, w2, b2, w3, freq, decay, bias):
    z = short_conv(z, conv_w, conv_b, rows)
    v, x1, x2 = jnp.split(z.astype(F32), HY_ORDER + 1, axis=-1)
    k_freq = hyena_filters(z.shape[1], w1, b1, w2, b2, w3, freq, decay)
    bias = bias.astype(F32)
    y = x1 * fft_long_conv(v, k_freq[:, 0], bias[0])
    y = x2 * fft_long_conv(y, k_freq[:, 1], bias[1])
    return y.astype(z.dtype)


def mlstm_zero_state(B):
    return (jnp.zeros((B, ML_HEADS, ML_DH, ML_DH), F32), jnp.zeros((B, ML_HEADS, ML_DH), F32),
            jnp.zeros((B, ML_HEADS), F32))


def mlstm_chunk_scan(q, k, v, li, lf, state):
    B, H, L, Dh = q.shape
    nc = L // ML_CHUNK

    def chunks(a):
        return jnp.moveaxis(a.reshape((B, H, nc, ML_CHUNK) + a.shape[3:]), 2, 0)

    causal = jnp.tril(jnp.ones((ML_CHUNK, ML_CHUNK), bool))

    def step(carry, inp):
        C, n, m = carry
        qc, kc, vc, lic, lfc = inp
        b = jnp.cumsum(lfc, axis=-1)
        d = jnp.where(causal, b[..., :, None] - b[..., None, :] + lic[..., None, :], -jnp.inf)
        g = b + m[..., None]
        m_t = jnp.maximum(g, d.max(-1))
        w_inter = jnp.exp(g - m_t)
        s = jnp.einsum('bhtd,bhsd->bhts', qc, kc) * jnp.exp(d - m_t[..., None])
        num = w_inter[..., None] * jnp.einsum('bhvd,bhtd->bhtv', C, qc) + jnp.einsum('bhts,bhsv->bhtv', s, vc)
        den = w_inter * jnp.einsum('bhd,bhtd->bht', n, qc) + s.sum(-1)
        h = num / jnp.maximum(jnp.abs(den), jnp.exp(-m_t))[..., None]
        a = b[..., -1:] - b + lic
        m_new = jnp.maximum(b[..., -1] + m, a.max(-1))
        wk = jnp.exp(a - m_new[..., None])
        dec = jnp.exp(b[..., -1] + m - m_new)
        C = dec[..., None, None] * C + jnp.einsum('bhs,bhsv,bhsd->bhvd', wk, vc, kc)
        n = dec[..., None] * n + jnp.einsum('bhs,bhsd->bhd', wk, kc)
        return (C, n, m_new), h

    state, h = lax.scan(step, state, (chunks(q), chunks(k), chunks(v), chunks(li), chunks(lf)))
    return jnp.moveaxis(h, 0, 2).reshape(B, H, L, Dh), state


def mlstm_prep(qk_pre, v_pre, gate_pre, rows, conv_w, conv_b, gate_b):
    B, L, _ = qk_pre.shape
    qk = jax.nn.silu(short_conv(qk_pre, conv_w, conv_b, rows)).astype(F32)

    def heads(a):
        return a.reshape(B, L, ML_HEADS, ML_DH).transpose(0, 2, 1, 3)

    q = heads(qk[..., :W_ML])
    k = heads(qk[..., W_ML:]) * (ML_DH ** -0.5)
    v = heads(v_pre.astype(F32))
    gates = (gate_pre.astype(F32).reshape(B, L, 4, ML_HEADS) + gate_b.astype(F32)).transpose(2, 0, 3, 1)
    return (q, k, v, gates[0], jax.nn.log_sigmoid(gates[1]), gates[2], jax.nn.log_sigmoid(gates[3]))


def mlstm_bidir(prep, state_f, state_b):
    q, k, v, li_f, lf_f, li_b, lf_b = prep
    h_f, st_f = mlstm_chunk_scan(q, k, v, li_f, lf_f, state_f)
    fl = lambda a: jnp.flip(a, axis=2)
    h_b, st_b = mlstm_chunk_scan(fl(q), fl(k), fl(v), fl(li_b), fl(lf_b), state_b)
    return h_f + fl(h_b), st_f, st_b


def mlstm_out(h, o_pre, norm_g):
    B, H, L, Dh = h.shape
    mu = jnp.mean(h, axis=-1, keepdims=True)
    var = jnp.mean(jnp.square(h - mu), axis=-1, keepdims=True)
    hn = ((h - mu) * lax.rsqrt(var + LN_EPS)).transpose(0, 2, 1, 3).reshape(B, L, W_ML)
    return (hn * norm_g.astype(F32) * jax.nn.sigmoid(o_pre.astype(F32))).astype(o_pre.dtype)


def s5_zero_state(B):
    return (jnp.zeros((B, S5_GROUPS, S5_STATE), F32), jnp.zeros((B, S5_GROUPS, S5_STATE), F32))


def s5_discretise(a_re, a_im, log_dt, b_re, b_im):
    a_re, a_im, b_re, b_im = (t.astype(F32) for t in (a_re, a_im, b_re, b_im))
    dt = jnp.exp(log_dt.astype(F32))[:, None]
    mag = jnp.exp(dt * a_re)
    ab_re, ab_im = mag * jnp.cos(dt * a_im), mag * jnp.sin(dt * a_im)
    den = jnp.square(a_re) + jnp.square(a_im)
    co_re = ((ab_re - 1.0) * a_re + ab_im * a_im) / den
    co_im = (ab_im * a_re - (ab_re - 1.0) * a_im) / den
    bb_re = co_re[..., None] * b_re - co_im[..., None] * b_im
    bb_im = co_re[..., None] * b_im + co_im[..., None] * b_re
    return ab_re, ab_im, bb_re, bb_im


def s5_combine(e1, e2):
    a1r, a1i, b1r, b1i = e1
    a2r, a2i, b2r, b2i = e2
    return (a1r * a2r - a1i * a2i, a1r * a2i + a1i * a2r,
            a2r * b1r - a2i * b1i + b2r, a2r * b1i + a2i * b1r + b2i)


def s5_direction(u, ab_re, ab_im, bb_re, bb_im, c_re, c_im, x0, readout):
    L = u.shape[1]
    bu_re = jnp.einsum('blgc,gpc->blgp', u, bb_re)
    bu_im = jnp.einsum('blgc,gpc->blgp', u, bb_im)
    x0_re, x0_im = x0
    bu_re = bu_re.at[:, 0].add(ab_re * x0_re - ab_im * x0_im)
    bu_im = bu_im.at[:, 0].add(ab_re * x0_im + ab_im * x0_re)
    a_re = jnp.broadcast_to(ab_re[None, None], (1, L) + ab_re.shape)
    a_im = jnp.broadcast_to(ab_im[None, None], (1, L) + ab_im.shape)
    _, _, s_re, s_im = lax.associative_scan(s5_combine, (a_re, a_im, bu_re, bu_im), axis=1)
    final = (s_re[:, -1], s_im[:, -1])
    if not readout:
        return None, final
    y = (jnp.einsum('blgp,gcp->blgc', s_re, c_re.astype(F32))
         - jnp.einsum('blgp,gcp->blgc', s_im, c_im.astype(F32)))
    return y, final


def s5_bidir(u, disc, c_re, c_im, x0_f, x0_b, readout):
    B, L, _ = u.shape
    ug = u.astype(F32).reshape(B, L, S5_GROUPS, S5_GROUP)
    y_f, st_f = s5_direction(ug, *disc[0], c_re[0], c_im[0], x0_f, readout)
    y_b, st_b = s5_direction(jnp.flip(ug, 1), *disc[1], c_re[1], c_im[1], x0_b, readout)
    y = y_f + jnp.flip(y_b, 1) if readout else None
    return y, st_f, st_b


def s5_out(y, u, d, glu_w, glu_b):
    B, L, _ = u.shape
    y = y.reshape(B, L, W_S5) + d.astype(F32) * u.astype(F32)
    z = jax.nn.gelu(y).astype(u.dtype)
    return z * jax.nn.sigmoid(z @ glu_w + glu_b)


def merge_branches(y_hy, y_ml, y_s5, gate_pre, w_hy_out, w_ml_out, w_s5_out, w_out):
    g_hy, g_ml, g_s5 = jnp.split(jax.nn.sigmoid(gate_pre), N_BRANCH, axis=-1)
    merged = g_hy * (y_hy @ w_hy_out) + g_ml * (y_ml @ w_ml_out) + g_s5 * (y_s5 @ w_s5_out)
    return merged @ w_out


def token_mixer(h_ctx, h_lat, rows, need_ctx, w_in, hy_p, ml_p, s5_p, out_p):
    hy_c, qk_c, v_c, o_c, gt_c, u_c, mg_c = jnp.split(h_ctx @ w_in, SPLIT_POINTS, axis=-1)
    hy_l, qk_l, v_l, o_l, gt_l, u_l, mg_l = jnp.split(h_lat @ w_in, SPLIT_POINTS, axis=-1)
    B = h_lat.shape[0]
    ml_conv_w, ml_conv_b, ml_gate_b, ml_norm_g = ml_p
    zm = mlstm_zero_state(B)
    hm_c, mst_f, mst_b = mlstm_bidir(mlstm_prep(qk_c, v_c, gt_c, 1, ml_conv_w, ml_conv_b, ml_gate_b), zm, zm)
    hm_l, _, _ = mlstm_bidir(mlstm_prep(qk_l, v_l, gt_l, rows, ml_conv_w, ml_conv_b, ml_gate_b), mst_f, mst_b)
    a_re, a_im, log_dt, b_re, b_im, c_re, c_im, s5_d, glu_w, glu_b = s5_p
    disc = [s5_discretise(a_re[i], a_im[i], log_dt[i], b_re[i], b_im[i]) for i in range(2)]
    zs = s5_zero_state(B)
    ys_c, sst_f, sst_b = s5_bidir(u_c, disc, c_re, c_im, zs, zs, need_ctx)
    ys_l, _, _ = s5_bidir(u_l, disc, c_re, c_im, sst_f, sst_b, True)
    y_lat = merge_branches(hyena_branch(hy_l, rows, *hy_p), mlstm_out(hm_l, o_l, ml_norm_g),
                           s5_out(ys_l, u_l, s5_d, glu_w, glu_b), mg_l, *out_p)
    if not need_ctx:
        return None, y_lat
    y_ctx = merge_branches(hyena_branch(hy_c, 1, *hy_p), mlstm_out(hm_c, o_c, ml_norm_g),
                           s5_out(ys_c, u_c, s5_d, glu_w, glu_b), mg_c, *out_p)
    return y_ctx, y_lat


def sq_relu_mlp(h, w1, w2):
    return jnp.square(jax.nn.relu(h @ w1)) @ w2


def setup_inputs(seed: int = 0) -> dict:
    key = jax.random.key(seed)
    ks = iter(jax.random.split(key, 64))

    def nrm(shape, scale=1.0):
        return scale * jax.random.normal(next(ks), shape, F32)

    H = ML_HEADS
    G, P, CG = S5_GROUPS, S5_STATE, S5_GROUP
    f_bias = jnp.linspace(3.0, 6.0, H, dtype=F32)
    gate_base = jnp.stack([jnp.zeros((H,), F32), f_bias, jnp.zeros((H,), F32), f_bias])
    n_idx = jnp.arange(P, dtype=F32)
    return {
        'x': nrm((BATCH, SEQ, D_MODEL)),
        'c': nrm((BATCH, D_MODEL)),
        'ctx': nrm((BATCH, CTX_LEN, D_MODEL)),
        'c_ctx': nrm((D_MODEL,)),
        'w_mod': nrm((DEPTH, D_MODEL, 6 * D_MODEL), 0.5 * D_MODEL ** -0.5),
        'b_mod': nrm((DEPTH, 6 * D_MODEL), 0.02),
        'w_in': nrm((DEPTH, D_MODEL, N_IN), D_MODEL ** -0.5),
        'hy_conv_w': nrm((DEPTH, 3, (HY_ORDER + 1) * W_HY), 0.5),
        'hy_conv_b': nrm((DEPTH, (HY_ORDER + 1) * W_HY), 0.02),
        'hy_ffn_w1': nrm((DEPTH, HY_FEAT, HY_HIDDEN), HY_FEAT ** -0.5),
        'hy_ffn_b1': nrm((DEPTH, HY_HIDDEN), 0.1),
        'hy_ffn_w2': nrm((DEPTH, HY_HIDDEN, HY_HIDDEN), HY_HIDDEN ** -0.5),
        'hy_ffn_b2': nrm((DEPTH, HY_HIDDEN), 0.1),
        'hy_ffn_w3': nrm((DEPTH, HY_HIDDEN, HY_ORDER * 2 * W_HY), 0.05 * HY_HIDDEN ** -0.5),
        'hy_sin_freq': 1.0 + nrm((DEPTH, HY_HIDDEN), 0.01),
        'hy_decay': jnp.linspace(HY_DECAY_MIN, HY_DECAY_MAX, W_HY, dtype=F32) + nrm((DEPTH, HY_ORDER, W_HY), 0.01),
        'hy_bias': nrm((DEPTH, HY_ORDER, W_HY)),
        'ml_conv_w': nrm((DEPTH, 3, 2 * W_ML), 0.5),
        'ml_conv_b': nrm((DEPTH, 2 * W_ML), 0.02),
        'ml_gate_b': gate_base + nrm((DEPTH, 4, H), 0.1),
        'ml_norm_g': 1.0 + nrm((DEPTH, W_ML), 0.02),
        's5_a_re': -0.5 + nrm((DEPTH, 2, G, P), 0.01),
        's5_a_im': math.pi * n_idx + nrm((DEPTH, 2, G, P), 0.01),
        's5_log_dt': jax.random.uniform(next(ks), (DEPTH, 2, G), F32, math.log(1e-3), math.log(1e-1)),
        's5_b_re': nrm((DEPTH, 2, G, P, CG), (2 * CG) ** -0.5),
        's5_b_im': nrm((DEPTH, 2, G, P, CG), (2 * CG) ** -0.5),
        's5_c_re': nrm((DEPTH, 2, G, CG, P), P ** -0.5),
        's5_c_im': nrm((DEPTH, 2, G, CG, P), P ** -0.5),
        's5_d': nrm((DEPTH, W_S5)),
        's5_glu_w': nrm((DEPTH, W_S5, W_S5), W_S5 ** -0.5),
        's5_glu_b': nrm((DEPTH, W_S5), 0.02),
        'w_hy_out': nrm((DEPTH, W_HY, D_MODEL), DEEPNORM_BETA * W_HY ** -0.5),
        'w_ml_out': nrm((DEPTH, W_ML, D_MODEL), DEEPNORM_BETA * W_ML ** -0.5),
        'w_s5_out': nrm((DEPTH, W_S5, D_MODEL), DEEPNORM_BETA * W_S5 ** -0.5),
        'w_out': nrm((DEPTH, D_MODEL, D_MODEL), DEEPNORM_BETA * D_MODEL ** -0.5),
        'ln1_g': 1.0 + nrm((DEPTH, D_MODEL), 0.02),
        'ln1_b': nrm((DEPTH, D_MODEL), 0.02),
        'ln2_g': 1.0 + nrm((DEPTH, D_MODEL), 0.02),
        'ln2_b': nrm((DEPTH, D_MODEL), 0.02),
        'w_ff1': nrm((DEPTH, D_MODEL, D_FF), DEEPNORM_BETA * D_MODEL ** -0.5),
        'w_ff2': nrm((DEPTH, D_FF, D_MODEL), DEEPNORM_BETA * D_FF ** -0.5),
    }


def reference(x, c, ctx, c_ctx, w_mod, b_mod, w_in, hy_conv_w, hy_conv_b, hy_ffn_w1, hy_ffn_b1,
              hy_ffn_w2, hy_ffn_b2, hy_ffn_w3, hy_sin_freq, hy_decay, hy_bias, ml_conv_w, ml_conv_b,
              ml_gate_b, ml_norm_g, s5_a_re, s5_a_im, s5_log_dt, s5_b_re, s5_b_im, s5_c_re, s5_c_im,
              s5_d, s5_glu_w, s5_glu_b, w_hy_out, w_ml_out, w_s5_out, w_out, ln1_g, ln1_b, ln2_g, ln2_b,
              w_ff1, w_ff2):
    rows = x.shape[1] // GRID_W
    silu_c = jax.nn.silu(c)
    silu_cc = jax.nn.silu(c_ctx)
    for l in range(DEPTH):
        need_ctx = l < DEPTH - 1
        mod_l = jnp.split((silu_c @ w_mod[l] + b_mod[l])[:, None, :], 6, axis=-1)
        mod_c = jnp.split(silu_cc @ w_mod[l] + b_mod[l], 6, axis=-1)
        hy_p = (hy_conv_w[l], hy_conv_b[l], hy_ffn_w1[l], hy_ffn_b1[l], hy_ffn_w2[l], hy_ffn_b2[l],
                hy_ffn_w3[l], hy_sin_freq[l], hy_decay[l], hy_bias[l])
        ml_p = (ml_conv_w[l], ml_conv_b[l], ml_gate_b[l], ml_norm_g[l])
        s5_p = (s5_a_re[l], s5_a_im[l], s5_log_dt[l], s5_b_re[l], s5_b_im[l], s5_c_re[l], s5_c_im[l],
                s5_d[l], s5_glu_w[l], s5_glu_b[l])
        out_p = (w_hy_out[l], w_ml_out[l], w_s5_out[l], w_out[l])
        y_ctx, y_lat = token_mixer(modulate(ctx, mod_c[0], mod_c[1]), modulate(x, mod_l[0], mod_l[1]),
                                   rows, need_ctx, w_in[l], hy_p, ml_p, s5_p, out_p)
        x = layer_norm(DEEPNORM_ALPHA * x + mod_l[2] * y_lat, ln1_g[l], ln1_b[l])
        x = layer_norm(DEEPNORM_ALPHA * x + mod_l[5] * sq_relu_mlp(modulate(x, mod_l[3], mod_l[4]), w_ff1[l], w_ff2[l]),
                       ln2_g[l], ln2_b[l])
        if need_ctx:
            ctx = layer_norm(DEEPNORM_ALPHA * ctx + mod_c[2] * y_ctx, ln1_g[l], ln1_b[l])
            ctx = layer_norm(DEEPNORM_ALPHA * ctx + mod_c[5] * sq_relu_mlp(modulate(ctx, mod_c[3], mod_c[4]), w_ff1[l], w_ff2[l]),
                             ln2_g[l], ln2_b[l])
    return x
```

```cpp
#include <hip/hip_runtime.h>
#include <hip/hip_cooperative_groups.h>
#include <cstdio>
#include <cstring>
namespace cg = cooperative_groups;

#define DI __device__ __forceinline__
#ifndef REP
#define REP 0
#endif
#ifndef REP0
#define REP0 0
#endif
#ifndef REPC
#define REPC 0
#endif
#ifndef PAIR
#define PAIR 0
#endif
#ifndef EN
#define EN 0xFFFF
#endif
#define OPAQUE(x) asm volatile("" : "+v"(x))
typedef unsigned short bfu;
using bf16x8 = __attribute__((ext_vector_type(8))) short;
using f32x4  = __attribute__((ext_vector_type(4))) float;
using f32x16 = __attribute__((ext_vector_type(16))) float;

#define DM 2048
#define NTOK 36864
#define NLAT 32768
#define NIN 12304
#define NTHR 512
#define ALPHA 1.41421356237309515f

constexpr size_t W1_WIN = 0;
constexpr size_t W1_WOUT = (size_t)NIN * 2048;
constexpr size_t W1_WHY = W1_WOUT + (size_t)2048 * 2048;
constexpr size_t W1_WML = W1_WHY + (size_t)2048 * 768;
constexpr size_t W1_WS5 = W1_WML + (size_t)2048 * 768;
constexpr size_t W1_GLU = W1_WS5 + (size_t)2048 * 768;
constexpr size_t W1_ELEMS = W1_GLU + (size_t)768 * 768;
constexpr size_t OFF_W1 = 0;
constexpr size_t OFF_H = OFF_W1 + W1_ELEMS * 2;
constexpr size_t OFF_CTX = OFF_H + (size_t)NTOK * 2048 * 2;
constexpr size_t OFF_MOD = OFF_CTX + (size_t)4096 * 2048 * 4;
constexpr size_t OFF_FILT = OFF_MOD + (size_t)2 * 17 * 12288 * 4;
constexpr size_t FILT_L = (size_t)2 * 768 * 4096 * 2;
constexpr size_t OFF_CNT = OFF_FILT + 2 * FILT_L + (size_t)2 * 768 * 512 * 2;
constexpr size_t OFF_STATS = OFF_CNT + 256;
constexpr size_t OFF_BIG = OFF_STATS + (size_t)2 * NTOK * 2 * 4;
constexpr size_t SEG = (size_t)NTOK * 768 * 2;
constexpr size_t B_ZHY = 0;
constexpr size_t B_ZML = B_ZHY + (size_t)2304 * NTOK * 2;
constexpr size_t B_ZGT = B_ZML + (size_t)NTOK * 3072 * 2;
constexpr size_t B_ZU = B_ZGT + (size_t)NTOK * 16 * 4;
constexpr size_t B_YHY = B_ZU + SEG;
constexpr size_t B_HF = B_YHY + SEG;
constexpr size_t B_HB = B_HF + SEG;
constexpr size_t B_YF = B_HB + SEG;
constexpr size_t B_YB = B_YF + SEG;
constexpr size_t B_END = B_YB + SEG;
constexpr size_t WS_NEED = (size_t)1073741824;
constexpr size_t BIG_SIZE = WS_NEED - OFF_BIG;
constexpr size_t B_W2 = BIG_SIZE - (size_t)2 * 8192 * 2048 * 2;
static_assert(B_END <= BIG_SIZE, "ws");
static_assert(B_W2 >= B_YF + SEG, "w2 may only overlap Yb");
static_assert((size_t)NTOK * 8192 * 2 <= B_W2, "hidden");

struct P {
  const float* in[41];
  float* out;
  unsigned char* ws;
};
struct PX : P { int wv; };
#define TIDX(p) ((p).wv * 64 + (int)__builtin_amdgcn_mbcnt_hi(~0u, __builtin_amdgcn_mbcnt_lo(~0u, 0u)))

DI float bf2f(bfu v) { return __uint_as_float(((unsigned)v) << 16); }
DI bfu f2bf(float x) { return __builtin_bit_cast(unsigned short, (__bf16)x); }
typedef float f32x2_t __attribute__((ext_vector_type(2)));
typedef __bf16 bf16x2_t __attribute__((ext_vector_type(2)));
DI unsigned pack2(float a, float b) { f32x2_t v = {a, b}; bf16x2_t r = __builtin_convertvector(v, bf16x2_t); return __builtin_bit_cast(unsigned, r); }
DI float lo16(unsigned u) { return __uint_as_float(u << 16); }
DI float hi16(unsigned u) { return __uint_as_float(u & 0xffff0000u); }
DI float sigmoidf_(float x) { return 1.f / (1.f + __expf(-x)); }
DI void sincos_f(float x, float& s, float& c) {
  const float n = rintf(x * 0.6366197723675814f);
  float r = fmaf(n, -1.5703125f, x);
  r = fmaf(n, -4.837512969970703125e-4f, r);
  r = fmaf(n, -7.54978995489188216e-8f, r);
  const int q = (int)n;
  const float r2 = r * r;
  const float sp = r + r * r2 * (-1.6666654611e-1f + r2 * (8.3321608736e-3f + r2 * (-1.9515295891e-4f)));
  const float cp = 1.f - 0.5f * r2 + r2 * r2 * (4.166664568298827e-2f + r2 * (-1.388731625493765e-3f + r2 * 2.443315711809948e-5f));
  const float ss = (q & 1) ? cp : sp;
  const float cc = (q & 1) ? sp : cp;
  s = (q & 2) ? -ss : ss;
  c = ((q + 1) & 2) ? -cc : cc;
}
DI float sin_f(float x) { float s_, c_; sincos_f(x, s_, c_); return s_; }
DI float wave_sum(float v) {
#pragma unroll
  for (int o = 32; o >= 1; o >>= 1) v += __shfl_xor(v, o);
  return v;
}
DI f32x16 mfma32(bf16x8 a, bf16x8 b, f32x16 c) { return __builtin_amdgcn_mfma_f32_32x32x16_bf16(a, b, c, 0, 0, 0); }
DI f32x4 mfma16(bf16x8 a, bf16x8 b, f32x4 c) { return __builtin_amdgcn_mfma_f32_16x16x32_bf16(a, b, c, 0, 0, 0); }
DI bf16x8 u4_to_bf8(uint4 u) { return __builtin_bit_cast(bf16x8, u); }

DI bfu* wsb(const PX& p, size_t off) { return (bfu*)(p.ws + off); }
DI float* wsf(const PX& p, size_t off) { return (float*)(p.ws + off); }
DI float* stream_row(const PX& p, int r) {
  return r < NLAT ? p.out + (size_t)r * DM : wsf(p, OFF_CTX) + (size_t)(r - NLAT) * DM;
}
DI const float* input_row(const PX& p, int r) {
  return r < NLAT ? p.in[0] + (size_t)r * DM : p.in[2] + (size_t)(r - NLAT) * DM;
}
DI int modrow(int r) { return r < NLAT ? (r >> 11) : 16; }
DI const float* mods(const PX& p, int l, int mb, int chunk) {
  return wsf(p, OFF_MOD) + ((size_t)(l * 17 + mb) * 12288 + chunk * 2048);
}

#define LDS3 __attribute__((address_space(3)))
DI int lds_byte(int r, int c) {
  const int st = (r >> 4) * 2 + (c >> 5), rr = r & 15, cc = c & 31, ob = rr * 64 + cc * 2;
  return st * 1024 + (ob ^ (((ob >> 9) & 1) << 5));
}
DI void stage_rc(int b, int& R, int& C) {
  const int st = b / 1024, sb = b % 1024, swz = sb ^ (((sb >> 9) & 1) << 5);
  R = (st >> 1) * 16 + swz / 64;
  C = (st & 1) * 32 + (swz % 64) / 2;
}
template <int HM>
DI void kloop256(const PX& p, f32x4 (&acc)[2][2][4][2], const bfu* __restrict__ A, const bfu* __restrict__ Bt, const int K,
                 const int brow, const int bcol, bfu* shm, const bool pre = false) {
  constexpr int BK = 64, HALF = 128, HT = HALF * BK;
  int tid_ = TIDX(p); OPAQUE(tid_);
  const int tid = tid_;
  const int wid = tid >> 6, lane = tid & 63, wr = wid >> 2, wc = wid & 3, fr = lane & 15, fq = lane >> 4;
#define SA(b, h) (shm + ((b) * 2 + (h)) * HT)
#define SB(b, h) (shm + (4 + (b) * 2 + (h)) * HT)
  unsigned oa0, oa1, obb0, obb1;
  { int r_, c_;
    stage_rc(tid * 16, r_, c_); oa0 = (unsigned)(r_ * K + c_) * 2u;
    { const int rho = r_ & 31, pr = (r_ & ~31) + 8 * ((rho & 15) >> 2) + 4 * (rho >> 4) + (rho & 3); obb0 = (unsigned)(pr * K + c_) * 2u; }
    stage_rc(tid * 16 + 8192, r_, c_); oa1 = (unsigned)(r_ * K + c_) * 2u;
    { const int rho = r_ & 31, pr = (r_ & ~31) + 8 * ((rho & 15) >> 2) + 4 * (rho >> 4) + (rho & 3); obb1 = (unsigned)(pr * K + c_) * 2u; } }
  const int wvb_ = p.wv * 1024;
#define STAGE_(Pp, BASE, br, kt, O0, O1)                                                                   \
  do {                                                                                                     \
    const char* _g = (const char*)(BASE + (long)(br) * K + (long)(kt) * BK);                               \
    __builtin_amdgcn_global_load_lds((const unsigned*)(_g + O0), (LDS3 unsigned*)((char*)(Pp) + wvb_), 16, 0, 0); \
    __builtin_amdgcn_global_load_lds((const unsigned*)(_g + O1), (LDS3 unsigned*)((char*)(Pp) + wvb_ + 8192), 16, 0, 0); \
  } while (0)
#define STAGEA(Pp, BASE, br, kt) STAGE_(Pp, BASE, br, kt, oa0, oa1)
#define STAGEB(Pp, BASE, br, kt) STAGE_(Pp, BASE, br, kt, obb0, obb1)
  const unsigned sbase_ = (unsigned)(size_t)shm;
  const unsigned fsw_ = (unsigned)((fr * 64 + fq * 16) ^ ((((fr * 64 + fq * 16) >> 9) & 1) << 5));
  const unsigned aA_ = sbase_ + wr * 8192 + fsw_;
  const unsigned aB_ = sbase_ + 65536 + wc * 4096 + fsw_;
#define DSR(dstv, addr, off) asm volatile("ds_read_b128 %0, %1 offset:%2" : "=v"(dstv) : "v"(addr), "n"(off) : "memory")
#define LDA(dst, b, h)                                                  \
  do {                                                                  \
    DSR(dst[0][0], aA_, (2 * (b) + (h)) * 16384 + 0);                   \
    DSR(dst[0][1], aA_, (2 * (b) + (h)) * 16384 + 1024);                \
    DSR(dst[1][0], aA_, (2 * (b) + (h)) * 16384 + 2048);                \
    DSR(dst[1][1], aA_, (2 * (b) + (h)) * 16384 + 3072);                \
    DSR(dst[2][0], aA_, (2 * (b) + (h)) * 16384 + 4096);                \
    DSR(dst[2][1], aA_, (2 * (b) + (h)) * 16384 + 5120);                \
    DSR(dst[3][0], aA_, (2 * (b) + (h)) * 16384 + 6144);                \
    DSR(dst[3][1], aA_, (2 * (b) + (h)) * 16384 + 7168);                \
  } while (0)
#define LDB(dst, b, h)                                                  \
  do {                                                                  \
    DSR(dst[0][0], aB_, (2 * (b) + (h)) * 16384 + 0);                   \
    DSR(dst[0][1], aB_, (2 * (b) + (h)) * 16384 + 1024);                \
    DSR(dst[1][0], aB_, (2 * (b) + (h)) * 16384 + 2048);                \
    DSR(dst[1][1], aB_, (2 * (b) + (h)) * 16384 + 3072);                \
  } while (0)
#define MMA(ai, bj, At_, Bt_)                                                                              \
  do {                                                                                                     \
    __builtin_amdgcn_s_setprio(1);                                                                         \
    for (int m = 0; m < 4; ++m)                                                                            \
      for (int n = 0; n < 2; ++n)                                                                          \
        for (int k = 0; k < 2; ++k)                                                                        \
          acc[ai][bj][m][n] = __builtin_amdgcn_mfma_f32_16x16x32_bf16(Bt_[n][k], At_[m][k], acc[ai][bj][m][n], 0, 0, 0); \
    __builtin_amdgcn_s_setprio(0);                                                                         \
  } while (0)
#define MMA1(bj, At_, Bt_) do { if (!HM) MMA(1, bj, At_, Bt_); } while (0)
#define WAIT_V(n) asm volatile("s_waitcnt vmcnt(" #n ")" ::: "memory")
#define WAIT_L8 asm volatile("s_waitcnt lgkmcnt(8)" ::: "memory")
#define WAIT_A(A_)                                                                                         \
  asm volatile("s_waitcnt lgkmcnt(0)"                                                                      \
               : "+v"(A_[0][0]), "+v"(A_[0][1]), "+v"(A_[1][0]), "+v"(A_[1][1]), "+v"(A_[2][0]), "+v"(A_[2][1]),   \
                 "+v"(A_[3][0]), "+v"(A_[3][1]) :: "memory")
#define WAIT_B(B_)                                                                                         \
  asm volatile("s_waitcnt lgkmcnt(0)" : "+v"(B_[0][0]), "+v"(B_[0][1]), "+v"(B_[1][0]), "+v"(B_[1][1]) :: "memory")
#define WAIT_AB(A_, B_)                                                                                    \
  asm volatile("s_waitcnt lgkmcnt(0)"                                                                      \
               : "+v"(A_[0][0]), "+v"(A_[0][1]), "+v"(A_[1][0]), "+v"(A_[1][1]), "+v"(A_[2][0]), "+v"(A_[2][1]),   \
                 "+v"(A_[3][0]), "+v"(A_[3][1]), "+v"(B_[0][0]), "+v"(B_[0][1]), "+v"(B_[1][0]), "+v"(B_[1][1])     \
               :: "memory")
#define BAR __builtin_amdgcn_s_barrier()
#define SCHED __builtin_amdgcn_sched_barrier(0)
#pragma unroll
  for (int ai = 0; ai < 2; ai++)
#pragma unroll
    for (int bj = 0; bj < 2; bj++)
#pragma unroll
      for (int m = 0; m < 4; m++)
#pragma unroll
        for (int n = 0; n < 2; n++) acc[ai][bj][m][n] = f32x4{0.f, 0.f, 0.f, 0.f};
  bf16x8 At[4][2], B0[2][2], B1[2][2];
  const int nt = K / BK;
  if (!pre) {
    STAGEB(SB(0, 0), Bt, bcol, 0); STAGEA(SA(0, 0), A, brow, 0);
    STAGEB(SB(0, 1), Bt, bcol + HALF, 0); STAGEA(SA(0, 1), A, brow + HALF, 0);
  }
  if (wr == 1) BAR;
  WAIT_V(4); BAR;
  STAGEB(SB(1, 0), Bt, bcol, 1); STAGEA(SA(1, 0), A, brow, 1); STAGEB(SB(1, 1), Bt, bcol + HALF, 1);
  WAIT_V(6); BAR;
#pragma unroll 1
  for (int t = 0; t < nt - 2; t += 2) {
    LDB(B0, 0, 0); SCHED; LDA(At, 0, 0); STAGEA(SA(1, 1), A, brow + HALF, t + 1);
    WAIT_L8; BAR; WAIT_AB(At, B0); MMA(0, 0, At, B0); BAR; SCHED;
    LDB(B1, 0, 1); STAGEB(SB(0, 0), Bt, bcol, t + 2);
    BAR; WAIT_B(B1); MMA(0, 1, At, B1); BAR;
    LDA(At, 0, 1); STAGEA(SA(0, 0), A, brow, t + 2);
    BAR; WAIT_A(At); MMA1(0, At, B0); BAR; SCHED;
    STAGEB(SB(0, 1), Bt, bcol + HALF, t + 2);
    WAIT_V(6); BAR; MMA1(1, At, B1); BAR;
    LDB(B0, 1, 0); SCHED; LDA(At, 1, 0); STAGEA(SA(0, 1), A, brow + HALF, t + 2);
    WAIT_L8; BAR; WAIT_AB(At, B0); MMA(0, 0, At, B0); BAR; SCHED;
    LDB(B1, 1, 1); STAGEB(SB(1, 0), Bt, bcol, t + 3);
    BAR; WAIT_B(B1); MMA(0, 1, At, B1); BAR;
    LDA(At, 1, 1); STAGEA(SA(1, 0), A, brow, t + 3);
    BAR; WAIT_A(At); MMA1(0, At, B0); BAR; SCHED;
    STAGEB(SB(1, 1), Bt, bcol + HALF, t + 3);
    WAIT_V(6); BAR; MMA1(1, At, B1); BAR;
  }
  { LDB(B0, 0, 0); LDA(At, 0, 0); STAGEA(SA(1, 1), A, brow + HALF, nt - 1);
    BAR; WAIT_AB(At, B0); MMA(0, 0, At, B0); BAR;
    LDB(B1, 0, 1); BAR; WAIT_B(B1); MMA(0, 1, At, B1); BAR;
    LDA(At, 0, 1); WAIT_V(4); BAR; WAIT_A(At); MMA1(0, At, B0); MMA1(1, At, B1); BAR; }
  { LDB(B0, 1, 0); LDA(At, 1, 0); WAIT_V(2); BAR; WAIT_AB(At, B0); MMA(0, 0, At, B0); BAR;
    LDB(B1, 1, 1); WAIT_V(0); BAR; WAIT_B(B1); MMA(0, 1, At, B1); BAR;
    LDA(At, 1, 1); BAR; WAIT_A(At); MMA1(0, At, B0); MMA1(1, At, B1); BAR; }
  if (wr == 0) BAR;
#undef SA
#undef SB
#undef STAGE_
#undef STAGEA
#undef STAGEB
#undef LDA
#undef DSR
#undef LDB
#undef MMA
#undef MMA1
#undef WAIT_V
#undef WAIT_L8
#undef WAIT_A
#undef WAIT_B
#undef WAIT_AB
#undef BAR
#undef SCHED
}
DI void kstage4(const PX& p, const bfu* __restrict__ A, const bfu* __restrict__ Bt, const int K, const int brow, const int bcol, bfu* shm) {
  constexpr int HALF = 128, HT = HALF * 64;
  int tid_ = TIDX(p); OPAQUE(tid_);
  const int tid = tid_;
  const int wvb_ = p.wv * 1024;
  unsigned oa0, oa1, obb0, obb1;
  { int r_, c_;
    stage_rc(tid * 16, r_, c_); oa0 = (unsigned)(r_ * K + c_) * 2u;
    { const int rho = r_ & 31, pr = (r_ & ~31) + 8 * ((rho & 15) >> 2) + 4 * (rho >> 4) + (rho & 3); obb0 = (unsigned)(pr * K + c_) * 2u; }
    stage_rc(tid * 16 + 8192, r_, c_); oa1 = (unsigned)(r_ * K + c_) * 2u;
    { const int rho = r_ & 31, pr = (r_ & ~31) + 8 * ((rho & 15) >> 2) + 4 * (rho >> 4) + (rho & 3); obb1 = (unsigned)(pr * K + c_) * 2u; } }
#define KS_(Pp, BASE, br, O0, O1)                                                                          \
  do {                                                                                                     \
    const char* _g = (const char*)(BASE + (long)(br) * K);                                                 \
    __builtin_amdgcn_global_load_lds((const unsigned*)(_g + O0), (LDS3 unsigned*)((char*)(Pp) + wvb_), 16, 0, 0); \
    __builtin_amdgcn_global_load_lds((const unsigned*)(_g + O1), (LDS3 unsigned*)((char*)(Pp) + wvb_ + 8192), 16, 0, 0); \
  } while (0)
  KS_(shm + 4 * HT, Bt, bcol, obb0, obb1);
  KS_(shm + 0 * HT, A, brow, oa0, oa1);
  KS_(shm + 5 * HT, Bt, bcol + HALF, obb0, obb1);
  KS_(shm + 1 * HT, A, brow + HALF, oa0, oa1);
#undef KS_
}
DI void tile_of(int L, int nM, int nN, int& pm, int& pn) {
  const int nwg = nM * nN;
  int wgid = L;
  { const int q = nwg / 8, r = nwg % 8, xcd = wgid % 8, off = wgid / 8;
    wgid = (xcd < r ? xcd * (q + 1) : r * (q + 1) + (xcd - r) * q) + off; }
  const int nig = 8 * nN, gid = wgid / nig, fm = gid * 8, gsz = min(nM - fm, 8);
  pm = fm + ((wgid % nig) % gsz);
  pn = (wgid % nig) / gsz;
}

enum { EPI_INPROJ = 0, EPI_GLU = 1, EPI_RES = 2, EPI_FF1 = 3, EPI_GATE = 4, EPI_MERGE = 5 };

template <int EPI, int HM>
DI void epi256(const PX& p, int l, f32x4 (&acc)[2][2][4][2], int brow, int bcol, int aux, bool src_input) {
  int tid_ = TIDX(p); OPAQUE(tid_);
  const int wid = tid_ >> 6, lane = tid_ & 63, wr = wid >> 2, wc = wid & 3, fr = lane & 15, fq = lane >> 4;
  f32x4 hg[2][2], hlg[2][2], hlb[2][2];
  if (EPI == EPI_RES) {
    const int mbt = modrow(brow);
#pragma unroll
    for (int bj = 0; bj < 2; bj++) {
      const int c0 = bcol + bj * 128 + wc * 32 + fq * 8;
      const float* gp = mods(p, l, mbt, aux) + c0;
      hg[bj][0] = *(const f32x4*)gp; hg[bj][1] = *(const f32x4*)(gp + 4);
      const int ll = (aux == 5) ? l : (l > 0 ? l - 1 : 0);
      const float* lg = p.in[aux == 5 ? 35 : 37] + ll * 2048 + c0;
      const float* lb = p.in[aux == 5 ? 36 : 38] + ll * 2048 + c0;
      hlg[bj][0] = *(const f32x4*)lg; hlg[bj][1] = *(const f32x4*)(lg + 4);
      hlb[bj][0] = *(const f32x4*)lb; hlb[bj][1] = *(const f32x4*)(lb + 4);
    }
  }
#pragma unroll
  for (int ai = 0; ai < (HM ? 1 : 2); ai++)
#pragma unroll
    for (int bj = 0; bj < 2; bj++)
#pragma unroll
      for (int m = 0; m < 4; m++) {
          const int row = brow + ai * 128 + wr * 64 + m * 16 + fr;
          const int col0 = bcol + bj * 128 + wc * 32 + fq * 8;
          const f32x4 va = acc[ai][bj][m][0], vb = acc[ai][bj][m][1];
          const float v[8] = {va[0], va[1], va[2], va[3], vb[0], vb[1], vb[2], vb[3]};
          if (EPI == EPI_INPROJ) {
            if (col0 < 2304) {
              bfu* d = wsb(p, OFF_BIG + B_ZHY) + (size_t)col0 * NTOK + row;
#pragma unroll
              for (int j = 0; j < 8; j++) d[(size_t)j * NTOK] = f2bf(v[j]);
            } else if (col0 < 5376) {
              uint4 o; o.x = pack2(v[0], v[1]); o.y = pack2(v[2], v[3]); o.z = pack2(v[4], v[5]); o.w = pack2(v[6], v[7]);
              *(uint4*)(wsb(p, OFF_BIG + B_ZML) + (size_t)row * 3072 + (col0 - 2304)) = o;
            } else {
              uint4 o; o.x = pack2(v[0], v[1]); o.y = pack2(v[2], v[3]); o.z = pack2(v[4], v[5]); o.w = pack2(v[6], v[7]);
              *(uint4*)(wsb(p, OFF_BIG + B_ZU) + (size_t)row * 768 + (col0 - 5376)) = o;
            }
          } else if (EPI == EPI_GLU) {
            const float* gbp = p.in[30] + l * 768 + col0;
            const f32x4 g0 = *(const f32x4*)gbp, g1 = *(const f32x4*)(gbp + 4);
            const float gb[8] = {g0[0], g0[1], g0[2], g0[3], g1[0], g1[1], g1[2], g1[3]};
            const uint4 z = *(const uint4*)(wsb(p, OFF_BIG + B_YF) + (size_t)row * 768 + col0);
            const unsigned zz[4] = {z.x, z.y, z.z, z.w};
            unsigned oo[4];
#pragma unroll
            for (int q = 0; q < 4; q++)
              oo[q] = pack2(lo16(zz[q]) * sigmoidf_(v[2 * q] + gb[2 * q]), hi16(zz[q]) * sigmoidf_(v[2 * q + 1] + gb[2 * q + 1]));
            *(uint4*)(wsb(p, OFF_BIG + B_YB) + (size_t)row * 768 + col0) = make_uint4(oo[0], oo[1], oo[2], oo[3]);
          } else if (EPI == EPI_RES) {
            const float* xp = (src_input ? input_row(p, row) : (const float*)stream_row(p, row)) + col0;
            const f32x4 g0 = hg[bj][0], g1 = hg[bj][1];
            f32x4 x0 = *(const f32x4*)xp, x1 = *(const f32x4*)(xp + 4);
            if (!src_input) {
              const float2 st = *(const float2*)(wsf(p, OFF_STATS) + ((size_t)(aux == 5 ? 0 : 1) * NTOK + row) * 2);
              const f32x4 lg0 = hlg[bj][0], lg1 = hlg[bj][1];
              const f32x4 lb0 = hlb[bj][0], lb1 = hlb[bj][1];
#pragma unroll
              for (int j = 0; j < 4; j++) {
                x0[j] = (x0[j] - st.x) * st.y * lg0[j] + lb0[j];
                x1[j] = (x1[j] - st.x) * st.y * lg1[j] + lb1[j];
              }
            }
            f32x4 o0, o1;
#pragma unroll
            for (int j = 0; j < 4; j++) { o0[j] = ALPHA * x0[j] + g0[j] * va[j]; o1[j] = ALPHA * x1[j] + g1[j] * vb[j]; }
            float* dp = stream_row(p, row) + col0;
            *(f32x4*)dp = o0;
            *(f32x4*)(dp + 4) = o1;
          } else if (EPI == EPI_FF1) {
            float t[8];
#pragma unroll
            for (int j = 0; j < 8; j++) { t[j] = fmaxf(v[j], 0.f); t[j] *= t[j]; }
            uint4 o; o.x = pack2(t[0], t[1]); o.y = pack2(t[2], t[3]); o.z = pack2(t[4], t[5]); o.w = pack2(t[6], t[7]);
            *(uint4*)(wsb(p, OFF_BIG) + (size_t)row * 8192 + col0) = o;
          } else if (EPI == EPI_GATE) {
            uint4 o;
            o.x = pack2(sigmoidf_(v[0]), sigmoidf_(v[1])); o.y = pack2(sigmoidf_(v[2]), sigmoidf_(v[3]));
            o.z = pack2(sigmoidf_(v[4]), sigmoidf_(v[5])); o.w = pack2(sigmoidf_(v[6]), sigmoidf_(v[7]));
            *(uint4*)(wsb(p, OFF_BIG + B_ZML) + (size_t)row * 2048 + col0) = o;
          } else if (EPI == EPI_MERGE) {
            const uint4 g = *(const uint4*)(wsb(p, OFF_BIG + B_ZML) + (size_t)row * 2048 + col0);
            uint4* d = (uint4*)(wsb(p, OFF_BIG + B_ZHY) + (size_t)row * 2048 + col0);
            uint4 old = make_uint4(0u, 0u, 0u, 0u);
            if (aux) old = *d;
            const unsigned gg[4] = {g.x, g.y, g.z, g.w}, od[4] = {old.x, old.y, old.z, old.w};
            unsigned oo[4];
#pragma unroll
            for (int q = 0; q < 4; q++)
              oo[q] = pack2(lo16(od[q]) + lo16(gg[q]) * v[2 * q], hi16(od[q]) + hi16(gg[q]) * v[2 * q + 1]);
            *d = make_uint4(oo[0], oo[1], oo[2], oo[3]);
          }
        }
}

template <int EPI>
DI void gemm_phase(const PX& p, int l, const bfu* A, const bfu* Bt, int K, int M, int nN, int aux, bool src_input,
                   unsigned char* smem, int Mh = 0) {
  const int nM = M >> 8;
  const int nF = nM * nN, nHm = Mh >> 7;
  const int total = nF + nHm * nN;
  constexpr bool EARLY = (EPI == EPI_FF1 || EPI == EPI_INPROJ);
  int L = blockIdx.x;
  if (L >= total) return;
  int brow, bcol;
  bool half;
  if (L < nF) { int pm, pn; tile_of(L, nM, nN, pm, pn); brow = pm * 256; bcol = pn * 256; half = false; }
  else { const int Lh = L - nF; brow = M + (Lh & 31) * 128; bcol = (Lh >> 5) * 256; half = true; }
  if (EARLY) kstage4(p, A, Bt, K, brow, bcol, (bfu*)smem);
  while (true) {
    const int Ln = L + gridDim.x;
    const bool has = Ln < total;
    int nbrow = 0, nbcol = 0;
    bool nhalf = false;
    if (has) {
      if (Ln < nF) { int pm, pn; tile_of(Ln, nM, nN, pm, pn); nbrow = pm * 256; nbcol = pn * 256; }
      else { const int Lh = Ln - nF; nbrow = M + (Lh & 31) * 128; nbcol = (Lh >> 5) * 256; nhalf = true; }
    }
    if (!half) {
      f32x4 acc[2][2][4][2];
      kloop256<0>(p, acc, A, Bt, K, brow, bcol, (bfu*)smem, EARLY);
      if (EARLY && has) kstage4(p, A, Bt, K, nbrow, nbcol, (bfu*)smem);
      epi256<EPI, 0>(p, l, acc, brow, bcol, aux, src_input);
    } else {
      f32x4 acc[2][2][4][2];
      kloop256<1>(p, acc, A, Bt, K, brow, bcol, (bfu*)smem, EARLY);
      if (EARLY && has) kstage4(p, A, Bt, K, nbrow, nbcol, (bfu*)smem);
      epi256<EPI, 1>(p, l, acc, brow, bcol, aux, src_input);
    }
    if (!has) break;
    L = Ln; brow = nbrow; bcol = nbcol; half = nhalf;
  }
}

template <int HM>
DI void merge_tile(const PX& p, int brow, int bcol, unsigned char* smem) {
  const bfu* hA = wsb(p, OFF_H);
  const bfu* W1 = wsb(p, OFF_W1);
#pragma unroll 1
  for (int br = 0; br < 3; br++) {
    const bfu* Y = wsb(p, OFF_BIG + (br == 0 ? B_YHY : (br == 1 ? B_HF : B_YB)));
    const bfu* Wo = W1 + (br == 0 ? W1_WHY : (br == 1 ? W1_WML : W1_WS5));
    {
      f32x4 acc[2][2][4][2];
      kloop256<HM>(p, acc, hA, W1 + W1_WIN + (size_t)(6160 + br * 2048) * 2048, 2048, brow, bcol, (bfu*)smem, br > 0);
      kstage4(p, Y, Wo, 768, brow, bcol, (bfu*)smem);
      epi256<EPI_GATE, HM>(p, 0, acc, brow, bcol, 0, false);
    }
    {
      f32x4 acc[2][2][4][2];
      kloop256<HM>(p, acc, Y, Wo, 768, brow, bcol, (bfu*)smem, true);
      if (br < 2) kstage4(p, hA, W1 + W1_WIN + (size_t)(6160 + (br + 1) * 2048) * 2048, 2048, brow, bcol, (bfu*)smem);
      epi256<EPI_MERGE, HM>(p, 0, acc, brow, bcol, br, false);
    }
  }
}
DI void merge_phase(const PX& p, int M, unsigned char* smem, int Mh = 0) {
  const int nM = M >> 8;
  const int nF = nM * 8, nHm = Mh >> 7;
  for (int L = blockIdx.x; L < nF + nHm * 8; L += gridDim.x) {
    if (L < nF) {
      int pm, pn;
      tile_of(L, nM, 8, pm, pn);
      merge_tile<0>(p, pm * 256, pn * 256, smem);
    } else {
      const int Lh = L - nF, pmh = Lh & 31, pn = Lh >> 5;
      merge_tile<1>(p, M + pmh * 128, pn * 256, smem);
    }
  }
}

DI void gate_gemm(const PX& p, int wgi, int nwg) {
  int tid_ = TIDX(p); OPAQUE(tid_);
  const int lane = tid_ & 63, w = tid_ >> 6, fr = lane & 15, kq = lane >> 4;
  const bfu* hA = wsb(p, OFF_H);
  const bfu* Wg = wsb(p, OFF_W1) + W1_WIN + (size_t)6144 * 2048 + (size_t)fr * 2048 + 8 * kq;
  float* Zgt = wsf(p, OFF_BIG + B_ZGT);
  for (int rb = wgi * 8 + w; rb < NTOK / 16; rb += nwg * 8) {
    const bfu* ap = hA + (size_t)(rb * 16 + fr) * 2048 + 8 * kq;
    f32x4 acc = f32x4{0.f, 0.f, 0.f, 0.f};
#pragma unroll 8
    for (int ks = 0; ks < 64; ks++) {
      const bf16x8 a = *(const bf16x8*)(ap + 32 * ks);
      const bf16x8 b = *(const bf16x8*)(Wg + 32 * ks);
      acc = mfma16(a, b, acc);
    }
#pragma unroll
    for (int j = 0; j < 4; j++) Zgt[(size_t)(rb * 16 + 4 * kq + j) * 16 + fr] = acc[j];
  }
}

DI void mod_partial(const PX& p, int it, float* sm) {
  int tid_ = TIDX(p); OPAQUE(tid_); const int tid = tid_;
  const int nb = it % 6, ks = (it / 6) % 32, l = it / 192;
  __syncthreads();
  for (int idx = tid; idx < 17 * 64; idx += NTHR) {
    const int j = idx >> 6, kk = idx & 63, k = ks * 64 + kk;
    const float c = j < 16 ? p.in[1][j * 2048 + k] : p.in[3][k];
    sm[idx] = c / (1.f + __expf(-c));
  }
  __syncthreads();
  float4 acc[17];
#pragma unroll
  for (int j = 0; j < 17; j++) acc[j] = make_float4(0.f, 0.f, 0.f, 0.f);
  const int n = nb * 2048 + tid * 4;
  const float* wp = p.in[4] + ((size_t)l * 2048 + ks * 64) * 12288 + n;
#pragma unroll 4
  for (int kk = 0; kk < 64; kk++) {
    const float4 wv = *(const float4*)(wp + (size_t)kk * 12288);
#pragma unroll
    for (int j = 0; j < 17; j++) {
      const float s = sm[j * 64 + kk];
      acc[j].x += s * wv.x; acc[j].y += s * wv.y; acc[j].z += s * wv.z; acc[j].w += s * wv.w;
    }
  }
  float* part = wsf(p, OFF_BIG) + ((size_t)(l * 32 + ks) * 17) * 12288 + n;
#pragma unroll
  for (int j = 0; j < 17; j++) *(float4*)(part + (size_t)j * 12288) = acc[j];
}

DI void cvt_tile(const PX& p, const float* __restrict__ src, bfu* __restrict__ dst, int K, int N, int tile, float* t, bool perm_in = false) {
  const int ntn = (N + 63) >> 6;
  const int kt = tile / ntn, nt = tile - kt * ntn;
  const int k0 = kt * 64, n0 = nt * 64;
  int tidc = TIDX(p); OPAQUE(tidc);
  __syncthreads();
#pragma unroll
  for (int i = 0; i < 2; i++) {
    const int idx = tidc + i * NTHR;
    const int kk = idx >> 4, n4 = (idx & 15) * 4, n = n0 + n4;
    float4 v = make_float4(0.f, 0.f, 0.f, 0.f);
    if (n < N) v = *(const float4*)(src + (size_t)(k0 + kk) * N + n);
    t[kk * 65 + n4] = v.x; t[kk * 65 + n4 + 1] = v.y; t[kk * 65 + n4 + 2] = v.z; t[kk * 65 + n4 + 3] = v.w;
  }
  __syncthreads();
  {
    const int nn = tidc >> 3, k8 = (tidc & 7) * 8, n = n0 + nn;
    if (n < N) {
      uint4 o;
      o.x = pack2(t[(k8 + 0) * 65 + nn], t[(k8 + 1) * 65 + nn]);
      o.y = pack2(t[(k8 + 2) * 65 + nn], t[(k8 + 3) * 65 + nn]);
      o.z = pack2(t[(k8 + 4) * 65 + nn], t[(k8 + 5) * 65 + nn]);
      o.w = pack2(t[(k8 + 6) * 65 + nn], t[(k8 + 7) * 65 + nn]);
      const int dn = (!perm_in || n < 5376 || n >= 6160) ? n : (n < 5392 ? n + 768 : n - 16);
      *(uint4*)(dst + (size_t)dn * K + k0 + k8) = o;
    }
  }
}
#define MIX_TILES 8496
DI void convert_mixer(const PX& p, int l, int tile, float* sm) {
  bfu* W1 = wsb(p, OFF_W1);
  if (tile < 6176) cvt_tile(p, p.in[6] + (size_t)l * 2048 * NIN, W1 + W1_WIN, 2048, NIN, tile, sm, true);
  else if (tile < 7200) cvt_tile(p, p.in[34] + (size_t)l * 2048 * 2048, W1 + W1_WOUT, 2048, 2048, tile - 6176, sm);
  else if (tile < 7584) cvt_tile(p, p.in[31] + (size_t)l * 768 * 2048, W1 + W1_WHY, 768, 2048, tile - 7200, sm);
  else if (tile < 7968) cvt_tile(p, p.in[32] + (size_t)l * 768 * 2048, W1 + W1_WML, 768, 2048, tile - 7584, sm);
  else if (tile < 8352) cvt_tile(p, p.in[33] + (size_t)l * 768 * 2048, W1 + W1_WS5, 768, 2048, tile - 7968, sm);
  else cvt_tile(p, p.in[29] + (size_t)l * 768 * 768, W1 + W1_GLU, 768, 768, tile - 8352, sm);
}
#define FFN_TILES 8192
DI void convert_ffn(const PX& p, int l, int tile, float* sm) {
  bfu* W2 = wsb(p, OFF_BIG + B_W2);
  if (tile < 4096) cvt_tile(p, p.in[39] + (size_t)l * 2048 * 8192, W2, 2048, 8192, tile, sm);
  else cvt_tile(p, p.in[40] + (size_t)l * 8192 * 2048, W2 + (size_t)8192 * 2048, 8192, 2048, tile - 4096, sm);
}

#define N_FILT_ITEMS 544
DI void filter_item(const PX& p, int it, float* sm) {
  int tid_ = TIDX(p); OPAQUE(tid_); const int tid = tid_;
  int l, L, j0;
  bfu* R;
  if (it < 256) { l = 0; L = 2048; j0 = it * 8; R = (bfu*)(p.ws + OFF_FILT); }
  else if (it < 512) { l = 1; L = 2048; j0 = (it - 256) * 8; R = (bfu*)(p.ws + OFF_FILT + FILT_L); }
  else { l = 0; L = 256; j0 = (it - 512) * 8; R = (bfu*)(p.ws + OFF_FILT + 2 * FILT_L); }
  float* feats = sm;
  float* h1 = sm + 320;
  float* h2 = sm + 320 + 512;
  const int lg = tid >> 6, i = tid & 63;
  const int j = j0 + lg;
  const float tj = (float)j / (float)(L - 1);
  __syncthreads();
  if (i < 33) {
    float f;
    if (i == 0) f = tj;
    else {
      const int bi = (i - 1) & 15;
      float bstep = 0.99999333333f, w0 = (L == 2048) ? 0.0030679615757712823f : 0.02454369260617026f;
      OPAQUE(bstep); OPAQUE(w0);
      const float band = 1e-4f + (float)bi * bstep;
      const float a = w0 * (float)j;
      const float ang = a * band;
      float sn, cs; sincos_f(ang, sn, cs);
      f = (i <= 16) ? cs : sn;
    }
    feats[lg * 40 + i] = f;
  }
  __syncthreads();
  const float fr = p.in[14][l * 64 + i];
  {
    float s = p.in[10][l * 64 + i];
    const float* w1 = p.in[9] + (size_t)l * 33 * 64;
#pragma unroll 11
    for (int f = 0; f < 33; f++) s += feats[lg * 40 + f] * w1[f * 64 + i];
    h1[lg * 64 + i] = sin_f(fr * s);
  }
  __syncthreads();
  {
    float s = p.in[12][l * 64 + i];
    const float* w2 = p.in[11] + (size_t)l * 64 * 64;
#pragma unroll 16
    for (int k = 0; k < 64; k++) s += h1[lg * 64 + k] * w2[k * 64 + i];
    h2[lg * 64 + i] = sin_f(fr * s);
  }
  __syncthreads();
  const float* w3 = p.in[13] + (size_t)l * 64 * 3072;
  float sacc[6][8];
#pragma unroll
  for (int q6 = 0; q6 < 6; q6++)
#pragma unroll
    for (int q = 0; q < 8; q++) sacc[q6][q] = 0.f;
#pragma unroll 4
  for (int k = 0; k < 64; k++) {
    float wv[6];
#pragma unroll
    for (int q6 = 0; q6 < 6; q6++) wv[q6] = w3[k * 3072 + tid + NTHR * q6];
#pragma unroll
    for (int q = 0; q < 8; q++) {
      const float hv = h2[q * 64 + k];
#pragma unroll
      for (int q6 = 0; q6 < 6; q6++) sacc[q6][q] += hv * wv[q6];
    }
  }
#pragma unroll
  for (int q6 = 0; q6 < 6; q6++) {
    const int n = tid + NTHR * q6;
    const int o = n / 1536, dir = (n % 1536) / 768, c = n % 768;
    const float dc = fabsf(p.in[15][(l * 2 + o) * 768 + c]);
    bfu* Rc = R + (size_t)(o * 768 + c) * (2 * L);
#pragma unroll
    for (int q = 0; q < 8; q++) {
      const int jj = j0 + q;
      const float tq = (float)jj / (float)(L - 1);
      const float val = sacc[q6][q] * expf(-tq * dc);
      if (dir == 0) Rc[L - jj] = f2bf(val);
      else if (jj > 0) Rc[L + jj] = f2bf(val);
    }
  }
}

DI void phase0(const PX& p, unsigned char* smem) {
  float* sm = (float*)smem;
  if (blockIdx.x == 0 && TIDX(p) < 64) ((unsigned*)(p.ws + OFF_CNT))[TIDX(p)] = 0u;
  const int n_mod = 384;
  const int total = n_mod + MIX_TILES + N_FILT_ITEMS;
  for (int it = blockIdx.x; it < total; it += gridDim.x) {
    if (it < n_mod) { if (EN & 256) mod_partial(p, it, sm); }
    else if (it < n_mod + N_FILT_ITEMS) { if (EN & 512) filter_item(p, it - n_mod, sm); }
    else convert_mixer(p, 0, it - n_mod - N_FILT_ITEMS, sm);
  }
}

DI void phase1(const PX& p) {
  const int total = 2 * 17 * 3072;
  int tx = TIDX(p); OPAQUE(tx);
  for (int u = blockIdx.x * NTHR + tx; u < total; u += gridDim.x * NTHR) {
    const int n = (u % 3072) * 4, j = (u / 3072) % 17, l = u / (3072 * 17);
    float4 s = *(const float4*)(p.in[5] + l * 12288 + n);
    for (int ks = 0; ks < 32; ks++) {
      const float4 v = *(const float4*)(wsf(p, OFF_BIG) + ((size_t)(l * 32 + ks) * 17 + j) * 12288 + n);
      s.x += v.x; s.y += v.y; s.z += v.z; s.w += v.w;
    }
    *(float4*)(wsf(p, OFF_MOD) + (size_t)(l * 17 + j) * 12288 + n) = s;
  }
}

DI void phase2(const PX& p) {
  int tid_ = TIDX(p); OPAQUE(tid_);
  const int lane = tid_ & 63;
  const int wg = blockIdx.x * 8 + (tid_ >> 6), nw = gridDim.x * 8;
  bfu* hA = wsb(p, OFF_H);
  const int rpw = (NTOK + nw - 1) / nw;
  float4 sa[8], sb[8];
#pragma unroll
  for (int i = 0; i < 8; i++) { sa[i] = make_float4(0.f, 0.f, 0.f, 0.f); sb[i] = make_float4(0.f, 0.f, 0.f, 0.f); }
  int mb_cur = -1;
  for (int k = 0; k < rpw; k++) {
    const int r = wg * rpw + k;
    if (r >= NTOK) break;
    const float* x = input_row(p, r);
    float4 v[8];
#pragma unroll
    for (int i = 0; i < 8; i++) v[i] = *(const float4*)(x + lane * 4 + 256 * i);
    const int mb = modrow(r);
    if (mb != mb_cur) {
      mb_cur = mb;
      const float* sh = mods(p, 0, mb, 0);
      const float* sc = mods(p, 0, mb, 1);
#pragma unroll
      for (int i = 0; i < 8; i++) {
        sa[i] = *(const float4*)(sh + lane * 4 + 256 * i);
        sb[i] = *(const float4*)(sc + lane * 4 + 256 * i);
      }
    }
#pragma unroll
    for (int i = 0; i < 8; i++) {
      const int c = lane * 4 + 256 * i;
      uint2 o;
      o.x = pack2(v[i].x * (1.f + sb[i].x) + sa[i].x, v[i].y * (1.f + sb[i].y) + sa[i].y);
      o.y = pack2(v[i].z * (1.f + sb[i].z) + sa[i].z, v[i].w * (1.f + sb[i].w) + sa[i].w);
      *(uint2*)(hA + (size_t)r * 2048 + c) = o;
    }
  }
}

DI void ln_pass(const PX& p, int l, int which, int M) {
  int tid_ = TIDX(p); OPAQUE(tid_);
  const int lane = tid_ & 63;
  const int wg = blockIdx.x * 8 + (tid_ >> 6), nw = gridDim.x * 8;
  const float* g = p.in[which ? 37 : 35] + l * 2048;
  const float* bta = p.in[which ? 38 : 36] + l * 2048;
  const bool emit = (which == 0) || (l + 1 < 2);
  const bool writex = (which == 1) && (l + 1 >= 2);
  float* stats = wsf(p, OFF_STATS) + (size_t)which * NTOK * 2;
  const int ml = which ? l + 1 : l;
  const int ch_sh = which ? 0 : 3, ch_sc = which ? 1 : 4;
  bfu* hA = wsb(p, OFF_H);
  const int rpw = (M + nw - 1) / nw;
  float4 gg[8], bb[8], sa[8], sb[8];
#pragma unroll
  for (int i = 0; i < 8; i++) {
    gg[i] = *(const float4*)(g + lane * 4 + 256 * i);
    bb[i] = *(const float4*)(bta + lane * 4 + 256 * i);
    sa[i] = make_float4(0.f, 0.f, 0.f, 0.f);
    sb[i] = make_float4(0.f, 0.f, 0.f, 0.f);
  }
  int mb_cur = -1;
  for (int k = 0; k < rpw; k++) {
    const int r = wg * rpw + k;
    if (r >= M) break;
    float* x = stream_row(p, r);
    float4 v[8];
    float s = 0.f;
#pragma unroll
    for (int i = 0; i < 8; i++) {
      v[i] = *(const float4*)(x + lane * 4 + 256 * i);
      s += v[i].x + v[i].y + v[i].z + v[i].w;
    }
    const int mb = modrow(r);
    if (emit && mb != mb_cur) {
      mb_cur = mb;
      const float* sh = mods(p, ml, mb, ch_sh);
      const float* sc = mods(p, ml, mb, ch_sc);
#pragma unroll
      for (int i = 0; i < 8; i++) {
        sa[i] = *(const float4*)(sh + lane * 4 + 256 * i);
        sb[i] = *(const float4*)(sc + lane * 4 + 256 * i);
      }
    }
    const float mu = wave_sum(s) * (1.f / 2048.f);
    float q = 0.f;
#pragma unroll
    for (int i = 0; i < 8; i++) {
      v[i].x -= mu; v[i].y -= mu; v[i].z -= mu; v[i].w -= mu;
      q += v[i].x * v[i].x + v[i].y * v[i].y + v[i].z * v[i].z + v[i].w * v[i].w;
    }
    const float rs = rsqrtf(wave_sum(q) * (1.f / 2048.f) + 1e-5f);
    if (!writex && lane == 0) *(float2*)(stats + (size_t)r * 2) = make_float2(mu, rs);
#pragma unroll
    for (int i = 0; i < 8; i++) {
      const int c = lane * 4 + 256 * i;
      float4 y;
      y.x = v[i].x * rs * gg[i].x + bb[i].x; y.y = v[i].y * rs * gg[i].y + bb[i].y;
      y.z = v[i].z * rs * gg[i].z + bb[i].z; y.w = v[i].w * rs * gg[i].w + bb[i].w;
      if (writex) *(float4*)(x + c) = y;
      if (emit) {
        uint2 o;
        o.x = pack2(y.x * (1.f + sb[i].x) + sa[i].x, y.y * (1.f + sb[i].y) + sa[i].y);
        o.y = pack2(y.z * (1.f + sb[i].z) + sa[i].z, y.w * (1.f + sb[i].w) + sa[i].w);
        *(uint2*)(hA + (size_t)r * 2048 + c) = o;
      }
    }
  }
}

DI void post_scan(const PX& p, int l, int M, unsigned char* smem) {
  {
    bfu* tl = (bfu*)smem;
    int tx = TIDX(p); OPAQUE(tx);
    const bfu* Zt = wsb(p, OFF_BIG + B_ZHY);
    bfu* Yh = wsb(p, OFF_BIG + B_YHY);
    const int nt = (M >> 6) * 12;
    for (int it = blockIdx.x; it < nt; it += gridDim.x) {
      const int r0 = (it / 12) * 64, c0 = (it % 12) * 64;
      __syncthreads();
#pragma unroll
      for (int i = 0; i < 8; i++) {
        const int idx = tx + i * NTHR, ci = idx >> 6, ti = idx & 63;
        tl[ci * 66 + ti] = Zt[(size_t)(c0 + ci) * NTOK + r0 + ti];
      }
      __syncthreads();
#pragma unroll
      for (int i = 0; i < 8; i++) {
        const int idx = tx + i * NTHR, ti = idx >> 6, ci = idx & 63;
        Yh[(size_t)(r0 + ti) * 768 + c0 + ci] = tl[ci * 66 + ti];
      }
    }
  }
  int tid_ = TIDX(p); OPAQUE(tid_);
  const int lane = tid_ & 63;
  const int wg = blockIdx.x * 8 + (tid_ >> 6), nw = gridDim.x * 8;
  bfu* Hf = wsb(p, OFF_BIG + B_HF);
  const bfu* Hb = wsb(p, OFF_BIG + B_HB);
  const bfu* Zml = wsb(p, OFF_BIG + B_ZML);
  bfu* Yf = wsb(p, OFF_BIG + B_YF);
  const bfu* Yb = wsb(p, OFF_BIG + B_YB);
  const bfu* Zu = wsb(p, OFF_BIG + B_ZU);
  const float* ng = p.in[20] + l * 768;
  const float* sd = p.in[28] + l * 768;
  float4 ngv[3], sdv[3];
#pragma unroll
  for (int i = 0; i < 3; i++) { ngv[i] = *(const float4*)(ng + lane * 12 + 4 * i); sdv[i] = *(const float4*)(sd + lane * 12 + 4 * i); }
  for (int r = wg; r < M; r += nw) {
    const size_t ro = (size_t)r * 768 + lane * 12;
    {
      float x[12];
      const uint2* hf = (const uint2*)(Hf + ro);
      const uint2* hb = (const uint2*)(Hb + ro);
      float s = 0.f;
#pragma unroll
      for (int i = 0; i < 3; i++) {
        const uint2 a = hf[i], bq = hb[i];
        x[4 * i] = lo16(a.x) + lo16(bq.x); x[4 * i + 1] = hi16(a.x) + hi16(bq.x);
        x[4 * i + 2] = lo16(a.y) + lo16(bq.y); x[4 * i + 3] = hi16(a.y) + hi16(bq.y);
        s += x[4 * i] + x[4 * i + 1] + x[4 * i + 2] + x[4 * i + 3];
      }
#pragma unroll
      for (int o = 8; o >= 1; o >>= 1) s += __shfl_xor(s, o);
      const float mu = s * (1.f / 192.f);
      float q = 0.f;
#pragma unroll
      for (int i = 0; i < 12; i++) { x[i] -= mu; q += x[i] * x[i]; }
#pragma unroll
      for (int o = 8; o >= 1; o >>= 1) q += __shfl_xor(q, o);
      const float rs = rsqrtf(q * (1.f / 192.f) + 1e-5f);
      const uint2* og = (const uint2*)(Zml + (size_t)r * 3072 + 2304 + lane * 12);
      const float4* gg = (const float4*)(ng + lane * 12);
#pragma unroll
      for (int i = 0; i < 3; i++) {
        const uint2 o = og[i];
        const float4 g4 = ngv[i];
        uint2 w_;
        w_.x = pack2(x[4 * i] * rs * g4.x * sigmoidf_(lo16(o.x)), x[4 * i + 1] * rs * g4.y * sigmoidf_(hi16(o.x)));
        w_.y = pack2(x[4 * i + 2] * rs * g4.z * sigmoidf_(lo16(o.y)), x[4 * i + 3] * rs * g4.w * sigmoidf_(hi16(o.y)));
        ((uint2*)(Hf + ro))[i] = w_;
      }
    }
    {
      const uint2* yf = (const uint2*)(Yf + ro);
      const uint2* yb = (const uint2*)(Yb + ro);
      const uint2* zu = (const uint2*)(Zu + ro);
      const float4* dd = (const float4*)(sd + lane * 12);
#pragma unroll
      for (int i = 0; i < 3; i++) {
        const uint2 a = yf[i], bq = yb[i], u = zu[i];
        const float4 d4 = sdv[i];
        float y[4];
        y[0] = lo16(a.x) + lo16(bq.x) + d4.x * lo16(u.x);
        y[1] = hi16(a.x) + hi16(bq.x) + d4.y * hi16(u.x);
        y[2] = lo16(a.y) + lo16(bq.y) + d4.z * lo16(u.y);
        y[3] = hi16(a.y) + hi16(bq.y) + d4.w * hi16(u.y);
#pragma unroll
        for (int j = 0; j < 4; j++) {
          const float uu = 0.7978845608028654f * (y[j] + 0.044715f * y[j] * y[j] * y[j]);
          y[j] = 0.5f * y[j] * (1.f + tanhf(uu));
        }
        uint2 w_;
        w_.x = pack2(y[0], y[1]); w_.y = pack2(y[2], y[3]);
        ((uint2*)(Yf + ro))[i] = w_;
      }
    }
  }
}

DI void s5_job(const PX& p, int l, int job, unsigned char* smem) {
  int tid_ = TIDX(p); OPAQUE(tid_); const int tid = tid_, lane = tid & 63, w = tid >> 6;
  const bool active = w < 4;
  const int cl = (w >> 1) & 1, hf = w & 1;
  const int chain = job * 2 + cl;
  const int g = chain >> 1, dir = chain & 1;
  const int b = lane & 15, kq = lane >> 4;
  const int pg = (l * 2 + dir) * 48 + g;
  const float* a_re = p.in[21] + (size_t)pg * 64;
  const float* a_im = p.in[22] + (size_t)pg * 64;
  const float dt = expf(p.in[23][pg]);
  const float* b_re = p.in[24] + (size_t)pg * 1024;
  const float* b_im = p.in[25] + (size_t)pg * 1024;
  const float* c_re = p.in[26] + (size_t)pg * 1024;
  const float* c_im = p.in[27] + (size_t)pg * 1024;
  float* ex = (float*)smem + cl * (2 * 32 * 64);
  bf16x8 Are[2], Aim[2], Cf[2];
  float lre[2][4], lim[2][4];
#pragma unroll
  for (int tt = 0; tt < 2; tt++) {
    const int tau = 2 * hf + tt;
    {
      const int pp = 16 * tau + (lane & 15);
      const float ar = a_re[pp], ai = a_im[pp];
      const float mag = expf(dt * ar);
      float sn0, cs0; sincos_f(dt * ai, sn0, cs0);
      const float abr = mag * cs0, abi = mag * sn0;
      const float den = ar * ar + ai * ai;
      const float cor = ((abr - 1.f) * ar + abi * ai) / den;
      const float coi = (abi * ar - (abr - 1.f) * ai) / den;
#pragma unroll
      for (int j = 0; j < 8; j++) {
        float vr = 0.f, vi = 0.f;
        if (kq < 2) {
          const float br = b_re[pp * 16 + 8 * kq + j], bi = b_im[pp * 16 + 8 * kq + j];
          vr = cor * br - coi * bi;
          vi = cor * bi + coi * br;
        }
        Are[tt][j] = (short)f2bf(vr);
        Aim[tt][j] = (short)f2bf(vi);
      }
    }
#pragma unroll
    for (int r = 0; r < 4; r++) {
      const int pp = 16 * tau + 4 * kq + r;
      const float mag = expf(dt * a_re[pp]);
      float sn1, cs1; sincos_f(dt * a_im[pp], sn1, cs1);
      lre[tt][r] = mag * cs1;
      lim[tt][r] = mag * sn1;
    }
  }
#pragma unroll
  for (int ks = 0; ks < 2; ks++) {
#pragma unroll
    for (int j = 0; j < 8; j++) {
      const int pp = 16 * (2 * hf + (j >> 2)) + 4 * kq + (j & 3);
      const float v = (ks == 0) ? c_re[b * 64 + pp] : -c_im[b * 64 + pp];
      Cf[ks][j] = (short)f2bf(v);
    }
  }
  f32x4 sre[2], sim[2];
#pragma unroll
  for (int tt = 0; tt < 2; tt++) { sre[tt] = f32x4{0.f, 0.f, 0.f, 0.f}; sim[tt] = f32x4{0.f, 0.f, 0.f, 0.f}; }
  const bfu* Zu = wsb(p, OFF_BIG + B_ZU) + g * 16 + 8 * (kq & 1);
  bfu* Y = wsb(p, OFF_BIG + (dir ? B_YB : B_YF)) + g * 16 + 4 * kq;
  __syncthreads();
  int gblk = 0;
#pragma unroll 1
  for (int seg = 0; seg < 2; seg++) {
    const int Lseg = seg ? 2048 : 256;
    const int tokbase = seg ? b * 2048 : NLAT + b * 256;
    const int nblk = Lseg >> 3;
    uint4 ucur[8], unext[8];
    if (active) {
#pragma unroll
      for (int s = 0; s < 8; s++) {
        const int t = dir ? Lseg - 1 - s : s;
        ucur[s] = *(const uint4*)(Zu + (size_t)(tokbase + t) * 768);
      }
    }
#pragma unroll 1
    for (int blk = 0; blk < nblk; blk++, gblk++) {
      float* exb = ex + (gblk & 1) * (32 * 64) + lane;
      f32x4 yp[8];
      if (active) {
        if (blk + 1 < nblk) {
#pragma unroll
          for (int s = 0; s < 8; s++) {
            const int st = (blk + 1) * 8 + s;
            const int t = dir ? Lseg - 1 - st : st;
            unext[s] = *(const uint4*)(Zu + (size_t)(tokbase + t) * 768);
          }
        }
#pragma unroll
        for (int s = 0; s < 8; s++) {
          const bf16x8 ub = u4_to_bf8(ucur[s]);
#pragma unroll
          for (int tt = 0; tt < 2; tt++) {
            f32x4 cr, ci;
#pragma unroll
            for (int r = 0; r < 4; r++) {
              cr[r] = lre[tt][r] * sre[tt][r] - lim[tt][r] * sim[tt][r];
              ci[r] = lre[tt][r] * sim[tt][r] + lim[tt][r] * sre[tt][r];
            }
            sre[tt] = mfma16(Are[tt], ub, cr);
            sim[tt] = mfma16(Aim[tt], ub, ci);
          }
          uint4 pr, pi;
          pr.x = pack2(sre[0][0], sre[0][1]); pr.y = pack2(sre[0][2], sre[0][3]);
          pr.z = pack2(sre[1][0], sre[1][1]); pr.w = pack2(sre[1][2], sre[1][3]);
          pi.x = pack2(sim[0][0], sim[0][1]); pi.y = pack2(sim[0][2], sim[0][3]);
          pi.z = pack2(sim[1][0], sim[1][1]); pi.w = pack2(sim[1][2], sim[1][3]);
          f32x4 y = f32x4{0.f, 0.f, 0.f, 0.f};
          y = mfma16(Cf[0], u4_to_bf8(pr), y);
          y = mfma16(Cf[1], u4_to_bf8(pi), y);
          yp[s] = y;
        }
        if (hf == 1) {
#pragma unroll
          for (int s = 0; s < 8; s++)
#pragma unroll
            for (int r = 0; r < 4; r++) exb[(s * 4 + r) * 64] = yp[s][r];
        }
      }
      __syncthreads();
      if (active && hf == 0) {
#pragma unroll
        for (int s = 0; s < 8; s++) {
          const int st = blk * 8 + s;
          const int t = dir ? Lseg - 1 - st : st;
          float q[4];
#pragma unroll
          for (int r = 0; r < 4; r++) q[r] = yp[s][r] + exb[(s * 4 + r) * 64];
          uint2 o;
          o.x = pack2(q[0], q[1]); o.y = pack2(q[2], q[3]);
          *(uint2*)(Y + (size_t)(tokbase + t) * 768) = o;
        }
      }
      if (active) {
#pragma unroll
        for (int s = 0; s < 8; s++) ucur[s] = unext[s];
      }
    }
  }
}

DI void mlstm_job(const PX& p, int l, int job, unsigned char* smem) {
  int tid_ = TIDX(p); OPAQUE(tid_); const int tid = tid_, lane = tid & 63, w = tid >> 6, lr = lane & 31, lh = lane >> 5;
  const int b = job >> 3, h = (job >> 1) & 3, dir = job & 1;
  bfu* sq = (bfu*)smem;
  bfu* sk = sq + 64 * 200;
  bfu* swk = sk + 64 * 200;
  bfu* svT = swk + 192 * 72;
  bfu* sS = svT + 224 * 72;
  float* sf = (float*)(sS + 64 * 72);
  float* rA = sf; float* muA = sf + 128; float* wkA = sf + 256; float* winA = sf + 384; float* emtA = sf + 512;
  float* scA = sf + 640; float* denA = sf + 656; float* cw = sf + 720;
  const bfu* Zml = wsb(p, OFF_BIG + B_ZML);
  const float* Zgt = wsf(p, OFF_BIG + B_ZGT);
  bfu* H = wsb(p, OFF_BIG + (dir ? B_HB : B_HF));
  __syncthreads();
  for (int x = tid; x < 384; x += NTHR) {
    const int ch = (x < 192) ? h * 192 + x : 768 + h * 192 + (x - 192);
#pragma unroll
    for (int j = 0; j < 3; j++) cw[j * 384 + x] = p.in[17][(l * 3 + j) * 1536 + ch];
    cw[1152 + x] = p.in[18][l * 1536 + ch];
  }
  for (int x = tid; x < 32 * 72; x += NTHR) svT[192 * 72 + x] = (x < 72) ? (bfu)0x3F80 : (bfu)0;
  const float gbi = p.in[19][l * 16 + (dir ? 8 : 0) + h];
  const float gbf = p.in[19][l * 16 + (dir ? 12 : 4) + h];
  f32x16 st[6];
#pragma unroll
  for (int i = 0; i < 6; i++)
#pragma unroll
    for (int r = 0; r < 16; r++) st[i][r] = 0.f;
  float m = 0.f;
  float pgi = 0.f, pgf = 0.f;
  if (w == 0) {
    const int t = dir ? 255 - lane : lane;
    const int tok = NLAT + b * 256 + t;
    pgi = Zgt[(size_t)tok * 16 + (dir ? 8 : 0) + h];
    pgf = Zgt[(size_t)tok * 16 + (dir ? 12 : 4) + h];
  }
#pragma unroll 1
  for (int cc = 0; cc < 36; cc++) {
    const int seg = cc >= 4;
    const int c = seg ? cc - 4 : cc;
    const int Lseg = seg ? 2048 : 256;
    const int RL = seg ? 64 : 256;
    const int tokbase = seg ? b * 2048 : NLAT + b * 256;
    {
      const int par = cc & 1;
      if (w == 0) {
        const float gi = pgi + gbi;
        const float gf = pgf + gbf;
        const float lf = fminf(gf, 0.f) - log1pf(expf(-fabsf(gf)));
        float bc = lf;
#pragma unroll
        for (int o = 1; o < 64; o <<= 1) { const float v = __shfl_up(bc, o); if (lane >= o) bc += v; }
        const float rr = gi - bc;
        float M = rr;
#pragma unroll
        for (int o = 1; o < 64; o <<= 1) { const float v = __shfl_up(M, o); if (lane >= o) M = fmaxf(M, v); }
        const float mu = fmaxf(m, M);
        const float b63 = __shfl(bc, 63), mu63 = __shfl(mu, 63);
        rA[par * 64 + lane] = rr;
        muA[par * 64 + lane] = mu;
        wkA[par * 64 + lane] = expf(rr - mu63);
        winA[par * 64 + lane] = expf(m - mu);
        emtA[par * 64 + lane] = expf(-(bc + mu));
        if (lane == 0) { scA[par * 4] = expf(m - mu63); scA[par * 4 + 1] = b63 + mu63; }
      }
      __syncthreads();
      if (w == 0 && cc + 1 < 36) {
        const int sg = (cc + 1) >= 4;
        const int pos = (sg ? cc + 1 - 4 : cc + 1) * 64 + lane;
        const int Ls = sg ? 2048 : 256;
        const int t = dir ? Ls - 1 - pos : pos;
        const int tok = (sg ? b * 2048 : NLAT + b * 256) + t;
        pgi = Zgt[(size_t)tok * 16 + (dir ? 8 : 0) + h];
        pgf = Zgt[(size_t)tok * 16 + (dir ? 12 : 4) + h];
      }
      const float dec = scA[par * 4];
      const float mnew = scA[par * 4 + 1];
#pragma unroll
      for (int i = 0; i < 9; i++) {
        const int u = tid + NTHR * i;
        const int which = i / 3;
        const int rem = u - which * 1536;
        const int tau = rem & 63;
        const int d8 = (rem >> 6) * 8;
        const int pos = c * 64 + tau;
        const int t = dir ? Lseg - 1 - pos : pos;
        const int tok = tokbase + t;
        if (which < 2) {
          const bfu* zp = Zml + (size_t)tok * 3072 + which * 768 + h * 192 + d8;
          const int tm = t & (RL - 1);
          const uint4 mid = *(const uint4*)zp;
          const uint4 lft = *(const uint4*)(zp - ((tm != 0) ? 3072 : 0));
          const uint4 rgt = *(const uint4*)(zp + ((tm != RL - 1) ? 3072 : 0));
          const float lvf = (tm != 0) ? 1.f : 0.f, rvf = (tm != RL - 1) ? 1.f : 0.f;
          const unsigned ml_[4] = {lft.x, lft.y, lft.z, lft.w};
          const unsigned mm_[4] = {mid.x, mid.y, mid.z, mid.w};
          const unsigned mr_[4] = {rgt.x, rgt.y, rgt.z, rgt.w};
          const float* cwx = cw + which * 192 + d8;
          float v[8];
#pragma unroll
          for (int e = 0; e < 8; e++) {
            const float a = (e & 1) ? hi16(ml_[e >> 1]) : lo16(ml_[e >> 1]);
            const float bm = (e & 1) ? hi16(mm_[e >> 1]) : lo16(mm_[e >> 1]);
            const float cr = (e & 1) ? hi16(mr_[e >> 1]) : lo16(mr_[e >> 1]);
            float s = cwx[e] * (a * lvf) + cwx[384 + e] * bm + cwx[768 + e] * (cr * rvf) + cwx[1152 + e];
            s = s / (1.f + __expf(-s));
            v[e] = s;
          }
          if (which == 0) {
            uint4 o;
            o.x = pack2(v[0], v[1]); o.y = pack2(v[2], v[3]); o.z = pack2(v[4], v[5]); o.w = pack2(v[6], v[7]);
            *(uint4*)(sq + tau * 200 + d8) = o;
          } else {
            const float wk = wkA[par * 64 + tau];
#pragma unroll
            for (int e = 0; e < 8; e++) v[e] *= 0.07216878364870323f;
            uint4 o;
            o.x = pack2(v[0], v[1]); o.y = pack2(v[2], v[3]); o.z = pack2(v[4], v[5]); o.w = pack2(v[6], v[7]);
            *(uint4*)(sk + tau * 200 + d8) = o;
#pragma unroll
            for (int e = 0; e < 8; e++) swk[(d8 + e) * 72 + tau] = f2bf(wk * v[e]);
          }
        } else {
          const bfu* zp = Zml + (size_t)tok * 3072 + 1536 + h * 192 + d8;
          const uint4 mid = *(const uint4*)zp;
          const unsigned mm_[4] = {mid.x, mid.y, mid.z, mid.w};
#pragma unroll
          for (int e = 0; e < 8; e++) svT[(d8 + e) * 72 + tau] = (bfu)((e & 1) ? (mm_[e >> 1] >> 16) : (mm_[e >> 1] & 0xffffu));
        }
      }
      __syncthreads();
      f32x16 num[2];
#pragma unroll
      for (int r = 0; r < 16; r++) { num[0][r] = 0.f; num[1][r] = 0.f; }
      if (w < 7) {
#pragma unroll
        for (int i = 0; i < 6; i++) {
#pragma unroll
          for (int s2 = 0; s2 < 2; s2++) {
            uint4 pk;
            pk.x = pack2(st[i][8 * s2 + 0], st[i][8 * s2 + 1]);
            pk.y = pack2(st[i][8 * s2 + 2], st[i][8 * s2 + 3]);
            pk.z = pack2(st[i][8 * s2 + 4], st[i][8 * s2 + 5]);
            pk.w = pack2(st[i][8 * s2 + 6], st[i][8 * s2 + 7]);
            const bf16x8 aop = u4_to_bf8(pk);
#pragma unroll
            for (int ti = 0; ti < 2; ti++) {
              const bfu* qp = sq + (ti * 32 + lr) * 200 + 32 * i + 16 * s2 + 4 * lh;
              const uint2 lo = *(const uint2*)qp;
              const uint2 hi = *(const uint2*)(qp + 8);
              const uint4 bq = make_uint4(lo.x, lo.y, hi.x, hi.y);
              num[ti] = mfma32(aop, u4_to_bf8(bq), num[ti]);
            }
          }
        }
#pragma unroll
        for (int ti = 0; ti < 2; ti++) {
          const float wi = winA[par * 64 + ti * 32 + lr];
#pragma unroll
          for (int r = 0; r < 16; r++) num[ti][r] *= wi;
        }
      }
      if (w < 4) {
        const int si = w >> 1, ti = w & 1;
        f32x16 acc;
#pragma unroll
        for (int r = 0; r < 16; r++) acc[r] = 0.f;
#pragma unroll
        for (int kk = 0; kk < 12; kk++) {
          const bf16x8 a = *(const bf16x8*)(sk + (si * 32 + lr) * 200 + kk * 16 + lh * 8);
          const bf16x8 bq = *(const bf16x8*)(sq + (ti * 32 + lr) * 200 + kk * 16 + lh * 8);
          acc = mfma32(a, bq, acc);
        }
        const int t = ti * 32 + lr;
        const float mut = muA[par * 64 + t];
#pragma unroll
        for (int g4 = 0; g4 < 4; g4++) {
          const int s0 = si * 32 + 8 * g4 + 4 * lh;
          float vv[4];
#pragma unroll
          for (int r4 = 0; r4 < 4; r4++) {
            const int s = s0 + r4;
            const float e = __expf(fminf(rA[par * 64 + s] - mut, 0.f));
            vv[r4] = (s <= t) ? acc[4 * g4 + r4] * e : 0.f;
          }
          uint2 o;
          o.x = pack2(vv[0], vv[1]); o.y = pack2(vv[2], vv[3]);
          *(uint2*)(sS + t * 72 + s0) = o;
        }
      }
      __syncthreads();
      if (w < 7) {
#pragma unroll
        for (int ti = 0; ti < 2; ti++) {
#pragma unroll
          for (int kk = 0; kk < 4; kk++) {
            const bf16x8 a = *(const bf16x8*)(svT + (32 * w + lr) * 72 + kk * 16 + lh * 8);
            const bf16x8 bs = *(const bf16x8*)(sS + (ti * 32 + lr) * 72 + kk * 16 + lh * 8);
            num[ti] = mfma32(a, bs, num[ti]);
          }
        }
        if (w == 6 && lh == 0) { denA[lr] = num[0][0]; denA[32 + lr] = num[1][0]; }
#pragma unroll
        for (int i = 0; i < 6; i++) {
#pragma unroll
          for (int r = 0; r < 16; r++) st[i][r] *= dec;
#pragma unroll
          for (int kk = 0; kk < 4; kk++) {
            const bf16x8 a = *(const bf16x8*)(swk + (32 * i + lr) * 72 + kk * 16 + lh * 8);
            const bf16x8 bv = *(const bf16x8*)(svT + (32 * w + lr) * 72 + kk * 16 + lh * 8);
            st[i] = mfma32(a, bv, st[i]);
          }
        }
      }
      __syncthreads();
      if (w < 6) {
#pragma unroll
        for (int ti = 0; ti < 2; ti++) {
          const int tl = ti * 32 + lr;
          const float dn = fmaxf(fabsf(denA[tl]), emtA[par * 64 + tl]);
          const float inv = 1.f / dn;
          const int pos = c * 64 + tl;
          const int t = dir ? Lseg - 1 - pos : pos;
          bfu* dst = H + (size_t)(tokbase + t) * 768 + h * 192 + 32 * w + 4 * lh;
#pragma unroll
          for (int g4 = 0; g4 < 4; g4++) {
            uint2 o;
            o.x = pack2(num[ti][4 * g4] * inv, num[ti][4 * g4 + 1] * inv);
            o.y = pack2(num[ti][4 * g4 + 2] * inv, num[ti][4 * g4 + 3] * inv);
            *(uint2*)(dst + 8 * g4) = o;
          }
        }
      }
      m = mnew;
    }
  }
}

DI void conv_taps(const PX& p, int l, int ch, float (&wt)[4]) {
  wt[0] = p.in[7][(l * 3 + 0) * 2304 + ch];
  wt[1] = p.in[7][(l * 3 + 1) * 2304 + ch];
  wt[2] = p.in[7][(l * 3 + 2) * 2304 + ch];
  wt[3] = p.in[8][l * 2304 + ch];
}
template <int L>
DI void hy_fill_copies(const PX& p, const bfu* __restrict__ Rg, bfu* cp) {
  constexpr int CSTR = 2 * L + 16;
  int tx = TIDX(p); OPAQUE(tx);
  bfu vv[(2 * L + NTHR - 1) / NTHR];
#pragma unroll
  for (int i = 0; i < (2 * L + NTHR - 1) / NTHR; i++) { const int x = tx + i * NTHR; vv[i] = (x < 2 * L) ? Rg[x < 2 * L ? x : 0] : (bfu)0; }
#pragma unroll
  for (int i = 0; i < (2 * L + NTHR - 1) / NTHR; i++) {
    const int x = tx + i * NTHR;
    if (x < 2 * L) {
      const bfu v = (x == 0) ? (bfu)0 : vv[i];
#pragma unroll
      for (int e = 0; e < 8; e++) cp[e * CSTR + x + e] = v;
    }
  }
}
template <int L, int TPW>
DI void hy_mfma(const PX& p, f32x4 (&acc)[TPW], const bfu* cp, const bfu* U) {
  constexpr int CSTR = 2 * L + 16, USTR = L + 8, NS = L / 32;
  int tx = TIDX(p); OPAQUE(tx);
  const int lane = tx & 63, w = tx >> 6;
  const int i = lane & 15, kq = lane >> 4, e = i & 7, ih = i >> 3;
  const bfu* cpe = cp + e * CSTR;
  const bfu* Ub = U + i * USTR + 8 * kq;
#pragma unroll
  for (int m = 0; m < TPW; m++) acc[m] = f32x4{0.f, 0.f, 0.f, 0.f};
  const int qb0 = L / 8 + kq - ih - 2 * (w * TPW);
  if constexpr (TPW == 16) {
    bf16x8 F[16];
#pragma unroll
    for (int m = 0; m < 16; m++) F[m] = *(const bf16x8*)(cpe + 8 * (qb0 - 2 * m));
#pragma unroll 1
    for (int k = 0; k < NS / 8; k++) {
#pragma unroll
      for (int j = 0; j < 8; j++) {
        const int ss = 8 * k + j;
        const int qb = qb0 + 4 * ss;
        F[(0 - 2 * j) & 15] = *(const bf16x8*)(cpe + 8 * qb);
        F[(1 - 2 * j) & 15] = *(const bf16x8*)(cpe + 8 * (qb - 2));
        const bf16x8 bfr = *(const bf16x8*)(Ub + 32 * ss);
#pragma unroll
        for (int m = 0; m < 16; m++) acc[m] = mfma16(F[(m - 2 * j) & 15], bfr, acc[m]);
      }
    }
  } else {
#pragma unroll 1
    for (int ss = 0; ss < NS; ss++) {
      const bf16x8 bfr = *(const bf16x8*)(Ub + 32 * ss);
      const int qb = qb0 + 4 * ss;
#pragma unroll
      for (int m = 0; m < TPW; m++) {
        const bf16x8 afr = *(const bf16x8*)(cpe + 8 * (qb - 2 * m));
        acc[m] = mfma16(afr, bfr, acc[m]);
      }
    }
  }
}
template <int L>
DI void hyena_job(const PX& p, int l, int c, unsigned char* smem) {
  constexpr int CSTR = 2 * L + 16, USTR = L + 8, TPW = L / 128, RL = (L == 2048) ? 64 : 256;
  int tid_ = TIDX(p); OPAQUE(tid_); const int tid = tid_, lane = tid & 63, w = tid >> 6;
  bfu* cp = (bfu*)smem;
  bfu* U = cp + 8 * CSTR;
  const int tokbase = (L == 2048) ? 0 : NLAT;
  const bfu* Rg = (const bfu*)(p.ws + OFF_FILT + ((L == 2048) ? (size_t)l * FILT_L : 2 * FILT_L)) + (size_t)c * (2 * L);
  const bfu* Zhy = wsb(p, OFF_BIG + B_ZHY);
  const bfu* zv = Zhy + (size_t)c * NTOK + tokbase;
  const bfu* zx1 = Zhy + (size_t)(768 + c) * NTOK + tokbase;
  const bfu* zx2 = Zhy + (size_t)(1536 + c) * NTOK + tokbase;
  float wv[4], w1[4], w2[4];
  conv_taps(p, l, c, wv);
  conv_taps(p, l, 768 + c, w1);
  conv_taps(p, l, 1536 + c, w2);
  const float bias0 = p.in[16][(l * 2 + 0) * 768 + c];
  const float bias1 = p.in[16][(l * 2 + 1) * 768 + c];
  __syncthreads();
  hy_fill_copies<L>(p, Rg, cp);
#pragma unroll
  for (int ui = 0; ui < (16 * (L / 8)) / NTHR; ui++) {
    const int u = tid + ui * NTHR;
    const int b = u / (L / 8), s8 = (u % (L / 8)) * 8;
    const bfu* zr = zv + b * L;
    const uint4 mid = *(const uint4*)(zr + s8);
    const bool lv = (s8 % RL != 0), rv = ((s8 + 8) % RL != 0);
    const float lft = bf2f(zr[lv ? s8 - 1 : s8]) * (lv ? 1.f : 0.f);
    const float rgt = bf2f(zr[rv ? s8 + 8 : s8]) * (rv ? 1.f : 0.f);
    float z[10];
    z[0] = lft; z[9] = rgt;
    z[1] = lo16(mid.x); z[2] = hi16(mid.x); z[3] = lo16(mid.y); z[4] = hi16(mid.y);
    z[5] = lo16(mid.z); z[6] = hi16(mid.z); z[7] = lo16(mid.w); z[8] = hi16(mid.w);
    float o[8];
#pragma unroll
    for (int e = 0; e < 8; e++) o[e] = wv[0] * z[e] + wv[1] * z[e + 1] + wv[2] * z[e + 2] + wv[3];
    uint4 pk;
    pk.x = pack2(o[0], o[1]); pk.y = pack2(o[2], o[3]); pk.z = pack2(o[4], o[5]); pk.w = pack2(o[6], o[7]);
    *(uint4*)(U + b * USTR + s8) = pk;
  }
  __syncthreads();
  const int b = lane & 15, kq = lane >> 4;
  uint2 y1pk[TPW];
  {
    f32x4 acc[TPW];
    hy_mfma<L, TPW>(p, acc, cp, U);
    int kq_o = kq;
    OPAQUE(kq_o);
#pragma unroll
    for (int m = 0; m < TPW; m++) {
      const int t0 = 16 * (w * TPW + m) + 4 * kq_o;
      const bfu* zr = zx1 + b * L;
      const uint2 mid = *(const uint2*)(zr + t0);
      const bool lv = (t0 % RL != 0), rv = ((t0 + 4) % RL != 0);
      const float lft = bf2f(zr[lv ? t0 - 1 : t0]) * (lv ? 1.f : 0.f);
      const float rgt = bf2f(zr[rv ? t0 + 4 : t0]) * (rv ? 1.f : 0.f);
      float z[6];
      z[0] = lft; z[5] = rgt; z[1] = lo16(mid.x); z[2] = hi16(mid.x); z[3] = lo16(mid.y); z[4] = hi16(mid.y);
      const uint2 vu = *(const uint2*)(U + b * USTR + t0);
      const float vv[4] = {lo16(vu.x), hi16(vu.x), lo16(vu.y), hi16(vu.y)};
      float y[4];
#pragma unroll
      for (int r = 0; r < 4; r++) {
        const float x1 = w1[0] * z[r] + w1[1] * z[r + 1] + w1[2] * z[r + 2] + w1[3];
        y[r] = x1 * (acc[m][r] + bias0 * vv[r]);
      }
      y1pk[m].x = pack2(y[0], y[1]);
      y1pk[m].y = pack2(y[2], y[3]);
    }
  }
  __syncthreads();
#pragma unroll
  for (int m = 0; m < TPW; m++) *(uint2*)(U + b * USTR + 16 * (w * TPW + m) + 4 * kq) = y1pk[m];
  hy_fill_copies<L>(p, Rg + (size_t)768 * (2 * L), cp);
  __syncthreads();
  {
    f32x4 acc[TPW];
    hy_mfma<L, TPW>(p, acc, cp, U);
    bfu* yrow = (bfu*)zv;
    int kq_o = kq;
    OPAQUE(kq_o);
#pragma unroll
    for (int m = 0; m < TPW; m++) {
      const int t0 = 16 * (w * TPW + m) + 4 * kq_o;
      const bfu* zr = zx2 + b * L;
      const uint2 mid = *(const uint2*)(zr + t0);
      const bool lv = (t0 % RL != 0), rv = ((t0 + 4) % RL != 0);
      const float lft = bf2f(zr[lv ? t0 - 1 : t0]) * (lv ? 1.f : 0.f);
      const float rgt = bf2f(zr[rv ? t0 + 4 : t0]) * (rv ? 1.f : 0.f);
      float z[6];
      z[0] = lft; z[5] = rgt; z[1] = lo16(mid.x); z[2] = hi16(mid.x); z[3] = lo16(mid.y); z[4] = hi16(mid.y);
      const uint2 vu = *(const uint2*)(U + b * USTR + t0);
      const float vv[4] = {lo16(vu.x), hi16(vu.x), lo16(vu.y), hi16(vu.y)};
      float y2[4];
#pragma unroll
      for (int r = 0; r < 4; r++) {
        const float x2 = w2[0] * z[r] + w2[1] * z[r + 1] + w2[2] * z[r + 2] + w2[3];
        y2[r] = x2 * (acc[m][r] + bias1 * vv[r]);
      }
      uint2 o2; o2.x = pack2(y2[0], y2[1]); o2.y = pack2(y2[2], y2[3]);
      *(uint2*)(yrow + b * L + t0) = o2;
    }
  }
}

DI void branch_phase(const PX& p, int l, int slot, unsigned char* smem, int mode = 3) {
  __shared__ int sjob;
  if (mode & 1)
  for (int jb = blockIdx.x; jb < 176; jb += gridDim.x) {
    if (jb < 48) { if (EN & 16) s5_job(p, l, jb, smem); }
    else { if (EN & 32) mlstm_job(p, l, jb - 48, smem); }
  }
  unsigned* cnt = (unsigned*)(p.ws + OFF_CNT) + slot;
  const int nj = (mode & 2) ? ((l == 0) ? 1536 : 768) : 0;
  while (true) {
    __syncthreads();
    if (TIDX(p) == 0) sjob = (int)atomicAdd(cnt, 1u);
    __syncthreads();
    const int j = sjob;
    if (j >= nj) break;
    if (j < 768) { if (EN & 64) hyena_job<2048>(p, l, j, smem); }
    else { if (EN & 128) hyena_job<256>(p, l, j - 768, smem); }
  }
}

DI void gbar(const PX& p, unsigned target) {
  asm volatile("s_waitcnt vmcnt(0)" ::: "memory");
  __syncthreads();
  if (TIDX(p) == 0) {
    unsigned* cnt = (unsigned*)(p.ws + OFF_CNT) + 32;
    __builtin_amdgcn_fence(__ATOMIC_RELEASE, "agent");
    asm volatile("s_waitcnt vmcnt(0)" ::: "memory");
    __hip_atomic_fetch_add(cnt, 1u, __ATOMIC_RELAXED, __HIP_MEMORY_SCOPE_AGENT);
    unsigned spins = 0;
    while (__hip_atomic_load(cnt, __ATOMIC_RELAXED, __HIP_MEMORY_SCOPE_AGENT) < target) {
      __builtin_amdgcn_s_sleep(2);
      if (++spins > (1u << 26)) break;
    }
    __builtin_amdgcn_fence(__ATOMIC_ACQUIRE, "agent");
    asm volatile("s_waitcnt vmcnt(0)" ::: "memory");
  }
  __syncthreads();
}
#define NPHASE 23
#define SMEM_BYTES 135168
__global__ void __launch_bounds__(NTHR) mega(P p0, int ph_lo, int ph_hi) {
  PX p;
  *(P*)&p = p0;
  p.wv = __builtin_amdgcn_readfirstlane((int)(threadIdx.x >> 6));
  __shared__ __attribute__((aligned(16))) unsigned char smem[SMEM_BYTES];
  cg::grid_group grid = cg::this_grid();
  for (int ph = ph_lo; ph < ph_hi; ph++) {
    if (ph == 0) { if (EN & 1) phase0(p, smem); if (REP0) { grid.sync(); phase0(p, smem); } }
    else if (ph == 1) { phase1(p); if (REP0) { grid.sync(); phase1(p); } }
    else if (ph == 2) { phase2(p); if (REP0) { grid.sync(); phase2(p); } }
    else {
      const int l = (ph - 3) / 10, i = (ph - 3) % 10;
      const int nrep = (((REP >> i) & 1) && (i != 5 || l == 0)) ? 2 : 1;
      for (int rp = 0; rp < nrep; rp++) {
      if (rp) grid.sync();
      const int M = (l == 0) ? NTOK : NLAT;
      const bfu* W1 = wsb(p, OFF_W1);
      const bfu* W2 = wsb(p, OFF_BIG + B_W2);
      if (i == 0) {
        if (EN & 2) gemm_phase<EPI_INPROJ>(p, l, wsb(p, OFF_H), W1 + W1_WIN, 2048, NTOK, 24, 0, false, smem);
        if (gridDim.x > 128) { if (blockIdx.x >= 128) gate_gemm(p, blockIdx.x - 128, gridDim.x - 128); }
        else gate_gemm(p, blockIdx.x, gridDim.x);
      }
      else if (i == 1) {
        if (EN & 4) branch_phase(p, l, l + 2 * rp, smem);
#if PAIR
        grid.sync();
        gemm_phase<EPI_INPROJ>(p, l, wsb(p, OFF_H), W1 + W1_WIN, 2048, NTOK, 25, 0, false, smem);
        grid.sync();
        branch_phase(p, l, l + 4, smem, PAIR);
#endif
      }
      else if (i == 2) post_scan(p, l, M, smem);
      else if (i == 3) gemm_phase<EPI_GLU>(p, l, wsb(p, OFF_BIG + B_YF), W1 + W1_GLU, 768, M, 3, 0, false, smem);
      else if (i == 4) { if (EN & 8) merge_phase(p, NLAT, smem, M - NLAT); }
      else if (i == 5) gemm_phase<EPI_RES>(p, l, wsb(p, OFF_BIG + B_ZHY), W1 + W1_WOUT, 2048, NLAT, 8, 2, l == 0, smem, M - NLAT);
      else if (i == 6) {
        ln_pass(p, l, 0, M);
        const int total = FFN_TILES + ((l == 0) ? MIX_TILES : 0);
        for (int rc = 0; rc < 1 + REPC; rc++)
        for (int it = blockIdx.x; it < total; it += gridDim.x) {
          if (it < FFN_TILES) convert_ffn(p, l, it, (float*)smem);
          else convert_mixer(p, l + 1, it - FFN_TILES, (float*)smem);
        }
      }
      else if (i == 7) gemm_phase<EPI_FF1>(p, l, wsb(p, OFF_H), W2, 2048, M, 32, 0, false, smem);
      else if (i == 8) gemm_phase<EPI_RES>(p, l, wsb(p, OFF_BIG), W2 + (size_t)8192 * 2048, 8192, NLAT, 8, 5, false, smem, M - NLAT);
      else ln_pass(p, l, 1, M);
      }
    }
    if (ph + 1 < ph_hi) {
      if (ph == ph_lo) grid.sync();
      else gbar(p, (unsigned)(ph - ph_lo) * gridDim.x);
    }
  }
}

#ifndef SINGLE_LAUNCH
#define SINGLE_LAUNCH 1
#endif

extern "C" void kernel_launch(void* const* d_in, const int* in_sizes, int n_in, void* d_out, int out_size, void* d_ws,
                              size_t ws_size, hipStream_t stream) {
  P p;
  memset(&p, 0, sizeof(p));
  for (int i = 0; i < 41; i++) p.in[i] = (const float*)d_in[i];
  p.out = (float*)d_out;
  p.ws = (unsigned char*)d_ws;
  if (ws_size < WS_NEED) { fprintf(stderr, "workspace too small: %zu < %zu\n", ws_size, WS_NEED); return; }
#if SINGLE_LAUNCH
  static int grid_blocks = 0;
  if (!grid_blocks) {
    int dev = 0, cus = 0, per_cu = 0;
    hipGetDevice(&dev);
    hipDeviceGetAttribute(&cus, hipDeviceAttributeMultiprocessorCount, dev);
    hipOccupancyMaxActiveBlocksPerMultiprocessor(&per_cu, mega, NTHR, 0);
    if (per_cu < 1) per_cu = 1;
    if (per_cu > 1) per_cu = 1;
    grid_blocks = cus * per_cu;
  }
  int lo = 0, hi = NPHASE;
  void* args[] = {&p, &lo, &hi};
  hipError_t e = hipLaunchCooperativeKernel((void*)mega, dim3(grid_blocks), dim3(NTHR), args, 0, stream);
  if (e != hipSuccess) fprintf(stderr, "cooperative launch failed: %s (grid %d)\n", hipGetErrorString(e), grid_blocks);
#else
  for (int ph = 0; ph < NPHASE; ph++) mega<<<dim3(256), dim3(NTHR), 0, stream>>>(p, ph, ph + 1);
#endif
}
```

```cpp
#include <hip/hip_runtime.h>
#include <hip/hip_cooperative_groups.h>
#include <cstdio>
#include <cstring>
namespace cg = cooperative_groups;

#define DI __device__ __forceinline__
#ifndef REP
#define REP 0
#endif
#ifndef REP0
#define REP0 0
#endif
#ifndef REPC
#define REPC 0
#endif
#ifndef PAIR
#define PAIR 0
#endif
#ifndef EN
#define EN 0xFFFF
#endif
#define OPAQUE(x) asm volatile("" : "+v"(x))
typedef unsigned short bfu;
using bf16x8 = __attribute__((ext_vector_type(8))) short;
using f32x4  = __attribute__((ext_vector_type(4))) float;
using f32x16 = __attribute__((ext_vector_type(16))) float;

#define DM 2048
#define NTOK 36864
#define NLAT 32768
#define NIN 12304
#define NTHR 512
#define ALPHA 1.41421356237309515f

constexpr size_t W1_WIN = 0;
constexpr size_t W1_WOUT = (size_t)NIN * 2048;
constexpr size_t W1_WHY = W1_WOUT + (size_t)2048 * 2048;
constexpr size_t W1_WML = W1_WHY + (size_t)2048 * 768;
constexpr size_t W1_WS5 = W1_WML + (size_t)2048 * 768;
constexpr size_t W1_GLU = W1_WS5 + (size_t)2048 * 768;
constexpr size_t W1_ELEMS = W1_GLU + (size_t)768 * 768;
constexpr size_t OFF_W1 = 0;
constexpr size_t OFF_H = OFF_W1 + W1_ELEMS * 2;
constexpr size_t OFF_CTX = OFF_H + (size_t)NTOK * 2048 * 2;
constexpr size_t OFF_MOD = OFF_CTX + (size_t)4096 * 2048 * 4;
constexpr size_t OFF_FILT = OFF_MOD + (size_t)2 * 17 * 12288 * 4;
constexpr size_t FILT_L = (size_t)2 * 768 * 4096 * 2;
constexpr size_t OFF_CNT = OFF_FILT + 2 * FILT_L + (size_t)2 * 768 * 512 * 2;
constexpr size_t OFF_STATS = OFF_CNT + 256;
constexpr size_t OFF_BIG = OFF_STATS + (size_t)2 * NTOK * 2 * 4;
constexpr size_t SEG = (size_t)NTOK * 768 * 2;
constexpr size_t B_ZHY = 0;
constexpr size_t B_ZML = B_ZHY + (size_t)2304 * NTOK * 2;
constexpr size_t B_ZGT = B_ZML + (size_t)NTOK * 3072 * 2;
constexpr size_t B_ZU = B_ZGT + (size_t)NTOK * 16 * 4;
constexpr size_t B_YHY = B_ZU + SEG;
constexpr size_t B_HF = B_YHY + SEG;
constexpr size_t B_HB = B_HF + SEG;
constexpr size_t B_YF = B_HB + SEG;
constexpr size_t B_YB = B_YF + SEG;
constexpr size_t B_END = B_YB + SEG;
constexpr size_t WS_NEED = (size_t)1073741824;
constexpr size_t BIG_SIZE = WS_NEED - OFF_BIG;
constexpr size_t B_W2 = BIG_SIZE - (size_t)2 * 8192 * 2048 * 2;
static_assert(B_END <= BIG_SIZE, "ws");
static_assert(B_W2 >= B_YF + SEG, "w2 may only overlap Yb");
static_assert((size_t)NTOK * 8192 * 2 <= B_W2, "hidden");

struct P {
  const float* in[41];
  float* out;
  unsigned char* ws;
};
struct PX : P { int wv; };
#define TIDX(p) ((p).wv * 64 + (int)__builtin_amdgcn_mbcnt_hi(~0u, __builtin_amdgcn_mbcnt_lo(~0u, 0u)))

DI float bf2f(bfu v) { return __uint_as_float(((unsigned)v) << 16); }
DI bfu f2bf(float x) { return __builtin_bit_cast(unsigned short, (__bf16)x); }
typedef float f32x2_t __attribute__((ext_vector_type(2)));
typedef __bf16 bf16x2_t __attribute__((ext_vector_type(2)));
DI unsigned pack2(float a, float b) { f32x2_t v = {a, b}; bf16x2_t r = __builtin_convertvector(v, bf16x2_t); return __builtin_bit_cast(unsigned, r); }
DI float lo16(unsigned u) { return __uint_as_float(u << 16); }
DI float hi16(unsigned u) { return __uint_as_float(u & 0xffff0000u); }
DI float sigmoidf_(float x) { return 1.f / (1.f + __expf(-x)); }
DI void sincos_f(float x, float& s, float& c) {
  const float n = rintf(x * 0.6366197723675814f);
  float r = fmaf(n, -1.5703125f, x);
  r = fmaf(n, -4.837512969970703125e-4f, r);
  r = fmaf(n, -7.54978995489188216e-8f, r);
  const int q = (int)n;
  const float r2 = r * r;
  const float sp = r + r * r2 * (-1.6666654611e-1f + r2 * (8.3321608736e-3f + r2 * (-1.9515295891e-4f)));
  const float cp = 1.f - 0.5f * r2 + r2 * r2 * (4.166664568298827e-2f + r2 * (-1.388731625493765e-3f + r2 * 2.443315711809948e-5f));
  const float ss = (q & 1) ? cp : sp;
  const float cc = (q & 1) ? sp : cp;
  s = (q & 2) ? -ss : ss;
  c = ((q + 1) & 2) ? -cc : cc;
}
DI float sin_f(float x) { float s_, c_; sincos_f(x, s_, c_); return s_; }
DI float wave_sum(float v) {
#pragma unroll
  for (int o = 32; o >= 1; o >>= 1) v += __shfl_xor(v, o);
  return v;
}
DI f32x16 mfma32(bf16x8 a, bf16x8 b, f32x16 c) { return __builtin_amdgcn_mfma_f32_32x32x16_bf16(a, b, c, 0, 0, 0); }
DI f32x4 mfma16(bf16x8 a, bf16x8 b, f32x4 c) { return __builtin_amdgcn_mfma_f32_16x16x32_bf16(a, b, c, 0, 0, 0); }
DI bf16x8 u4_to_bf8(uint4 u) { return __builtin_bit_cast(bf16x8, u); }

DI bfu* wsb(const PX& p, size_t off) { return (bfu*)(p.ws + off); }
DI float* wsf(const PX& p, size_t off) { return (float*)(p.ws + off); }
DI float* stream_row(const PX& p, int r) {
  return r < NLAT ? p.out + (size_t)r * DM : wsf(p, OFF_CTX) + (size_t)(r - NLAT) * DM;
}
DI const float* input_row(const PX& p, int r) {
  return r < NLAT ? p.in[0] + (size_t)r * DM : p.in[2] + (size_t)(r - NLAT) * DM;
}
DI int modrow(int r) { return r < NLAT ? (r >> 11) : 16; }
DI const float* mods(const PX& p, int l, int mb, int chunk) {
  return wsf(p, OFF_MOD) + ((size_t)(l * 17 + mb) * 12288 + chunk * 2048);
}

#define LDS3 __attribute__((address_space(3)))
DI int lds_byte(int r, int c) {
  const int st = (r >> 4) * 2 + (c >> 5), rr = r & 15, cc = c & 31, ob = rr * 64 + cc * 2;
  return st * 1024 + (ob ^ (((ob >> 9) & 1) << 5));
}
DI void stage_rc(int b, int& R, int& C) {
  const int st = b / 1024, sb = b % 1024, swz = sb ^ (((sb >> 9) & 1) << 5);
  R = (st >> 1) * 16 + swz / 64;
  C = (st & 1) * 32 + (swz % 64) / 2;
}
template <int HM>
DI void kloop256(const PX& p, f32x4 (&acc)[2][2][4][2], const bfu* __restrict__ A, const bfu* __restrict__ Bt, const int K,
                 const int brow, const int bcol, bfu* shm, const bool pre = false) {
  constexpr int BK = 64, HALF = 128, HT = HALF * BK;
  int tid_ = TIDX(p); OPAQUE(tid_);
  const int tid = tid_;
  const int wid = tid >> 6, lane = tid & 63, wr = wid >> 2, wc = wid & 3, fr = lane & 15, fq = lane >> 4;
#define SA(b, h) (shm + ((b) * 2 + (h)) * HT)
#define SB(b, h) (shm + (4 + (b) * 2 + (h)) * HT)
  unsigned oa0, oa1, obb0, obb1;
  { int r_, c_;
    stage_rc(tid * 16, r_, c_); oa0 = (unsigned)(r_ * K + c_) * 2u;
    { const int rho = r_ & 31, pr = (r_ & ~31) + 8 * ((rho & 15) >> 2) + 4 * (rho >> 4) + (rho & 3); obb0 = (unsigned)(pr * K + c_) * 2u; }
    stage_rc(tid * 16 + 8192, r_, c_); oa1 = (unsigned)(r_ * K + c_) * 2u;
    { const int rho = r_ & 31, pr = (r_ & ~31) + 8 * ((rho & 15) >> 2) + 4 * (rho >> 4) + (rho & 3); obb1 = (unsigned)(pr * K + c_) * 2u; } }
  const int wvb_ = p.wv * 1024;
#define STAGE_(Pp, BASE, br, kt, O0, O1)                                                                   \
  do {                                                                                                     \
    const char* _g = (const char*)(BASE + (long)(br) * K + (long)(kt) * BK);                               \
    __builtin_amdgcn_global_load_lds((const unsigned*)(_g + O0), (LDS3 unsigned*)((char*)(Pp) + wvb_), 16, 0, 0); \
    __builtin_amdgcn_global_load_lds((const unsigned*)(_g + O1), (LDS3 unsigned*)((char*)(Pp) + wvb_ + 8192), 16, 0, 0); \
  } while (0)
#define STAGEA(Pp, BASE, br, kt) STAGE_(Pp, BASE, br, kt, oa0, oa1)
#define STAGEB(Pp, BASE, br, kt) STAGE_(Pp, BASE, br, kt, obb0, obb1)
  const unsigned sbase_ = (unsigned)(size_t)shm;
  const unsigned fsw_ = (unsigned)((fr * 64 + fq * 16) ^ ((((fr * 64 + fq * 16) >> 9) & 1) << 5));
  const unsigned aA_ = sbase_ + wr * 8192 + fsw_;
  const unsigned aB_ = sbase_ + 65536 + wc * 4096 + fsw_;
#define DSR(dstv, addr, off) asm volatile("ds_read_b128 %0, %1 offset:%2" : "=v"(dstv) : "v"(addr), "n"(off) : "memory")
#define LDA(dst, b, h)                                                  \
  do {                                                                  \
    DSR(dst[0][0], aA_, (2 * (b) + (h)) * 16384 + 0);                   \
    DSR(dst[0][1], aA_, (2 * (b) + (h)) * 16384 + 1024);                \
    DSR(dst[1][0], aA_, (2 * (b) + (h)) * 16384 + 2048);                \
    DSR(dst[1][1], aA_, (2 * (b) + (h)) * 16384 + 3072);                \
    DSR(dst[2][0], aA_, (2 * (b) + (h)) * 16384 + 4096);                \
    DSR(dst[2][1], aA_, (2 * (b) + (h)) * 16384 + 5120);                \
    DSR(dst[3][0], aA_, (2 * (b) + (h)) * 16384 + 6144);                \
    DSR(dst[3][1], aA_, (2 * (b) + (h)) * 16384 + 7168);                \
  } while (0)
#define LDB(dst, b, h)                                                  \
  do {                                                                  \
    DSR(dst[0][0], aB_, (2 * (b) + (h)) * 16384 + 0);                   \
    DSR(dst[0][1], aB_, (2 * (b) + (h)) * 16384 + 1024);                \
    DSR(dst[1][0], aB_, (2 * (b) + (h)) * 16384 + 2048);                \
    DSR(dst[1][1], aB_, (2 * (b) + (h)) * 16384 + 3072);                \
  } while (0)
#define MMA(ai, bj, At_, Bt_)                                                                              \
  do {                                                                                                     \
    __builtin_amdgcn_s_setprio(1);                                                                         \
    for (int m = 0; m < 4; ++m)                                                                            \
      for (int n = 0; n < 2; ++n)                                                                          \
        for (int k = 0; k < 2; ++k)                                                                        \
          acc[ai][bj][m][n] = __builtin_amdgcn_mfma_f32_16x16x32_bf16(Bt_[n][k], At_[m][k], acc[ai][bj][m][n], 0, 0, 0); \
    __builtin_amdgcn_s_setprio(0);                                                                         \
  } while (0)
#define MMA1(bj, At_, Bt_) do { if (!HM) MMA(1, bj, At_, Bt_); } while (0)
#define WAIT_V(n) asm volatile("s_waitcnt vmcnt(" #n ")" ::: "memory")
#define WAIT_L8 asm volatile("s_waitcnt lgkmcnt(8)" ::: "memory")
#define WAIT_A(A_)                                                                                         \
  asm volatile("s_waitcnt lgkmcnt(0)"                                                                      \
               : "+v"(A_[0][0]), "+v"(A_[0][1]), "+v"(A_[1][0]), "+v"(A_[1][1]), "+v"(A_[2][0]), "+v"(A_[2][1]),   \
                 "+v"(A_[3][0]), "+v"(A_[3][1]) :: "memory")
#define WAIT_B(B_)                                                                                         \
  asm volatile("s_waitcnt lgkmcnt(0)" : "+v"(B_[0][0]), "+v"(B_[0][1]), "+v"(B_[1][0]), "+v"(B_[1][1]) :: "memory")
#define WAIT_AB(A_, B_)                                                                                    \
  asm volatile("s_waitcnt lgkmcnt(0)"                                                                      \
               : "+v"(A_[0][0]), "+v"(A_[0][1]), "+v"(A_[1][0]), "+v"(A_[1][1]), "+v"(A_[2][0]), "+v"(A_[2][1]),   \
                 "+v"(A_[3][0]), "+v"(A_[3][1]), "+v"(B_[0][0]), "+v"(B_[0][1]), "+v"(B_[1][0]), "+v"(B_[1][1])     \
               :: "memory")
#define BAR __builtin_amdgcn_s_barrier()
#define SCHED __builtin_amdgcn_sched_barrier(0)
#pragma unroll
  for (int ai = 0; ai < 2; ai++)
#pragma unroll
    for (int bj = 0; bj < 2; bj++)
#pragma unroll
      for (int m = 0; m < 4; m++)
#pragma unroll
        for (int n = 0; n < 2; n++) acc[ai][bj][m][n] = f32x4{0.f, 0.f, 0.f, 0.f};
  bf16x8 At[4][2], B0[2][2], B1[2][2];
  const int nt = K / BK;
  if (!pre) {
    STAGEB(SB(0, 0), Bt, bcol, 0); STAGEA(SA(0, 0), A, brow, 0);
    STAGEB(SB(0, 1), Bt, bcol + HALF, 0); STAGEA(SA(0, 1), A, brow + HALF, 0);
  }
  if (wr == 1) BAR;
  WAIT_V(4); BAR;
  STAGEB(SB(1, 0), Bt, bcol, 1); STAGEA(SA(1, 0), A, brow, 1); STAGEB(SB(1, 1), Bt, bcol + HALF, 1);
  WAIT_V(6); BAR;
#pragma unroll 1
  for (int t = 0; t < nt - 2; t += 2) {
    LDB(B0, 0, 0); SCHED; LDA(At, 0, 0); STAGEA(SA(1, 1), A, brow + HALF, t + 1);
    WAIT_L8; BAR; WAIT_AB(At, B0); MMA(0, 0, At, B0); BAR; SCHED;
    LDB(B1, 0, 1); STAGEB(SB(0, 0), Bt, bcol, t + 2);
    BAR; WAIT_B(B1); MMA(0, 1, At, B1); BAR;
    LDA(At, 0, 1); STAGEA(SA(0, 0), A, brow, t + 2);
    BAR; WAIT_A(At); MMA1(0, At, B0); BAR; SCHED;
    STAGEB(SB(0, 1), Bt, bcol + HALF, t + 2);
    WAIT_V(6); BAR; MMA1(1, At, B1); BAR;
    LDB(B0, 1, 0); SCHED; LDA(At, 1, 0); STAGEA(SA(0, 1), A, brow + HALF, t + 2);
    WAIT_L8; BAR; WAIT_AB(At, B0); MMA(0, 0, At, B0); BAR; SCHED;
    LDB(B1, 1, 1); STAGEB(SB(1, 0), Bt, bcol, t + 3);
    BAR; WAIT_B(B1); MMA(0, 1, At, B1); BAR;
    LDA(At, 1, 1); STAGEA(SA(1, 0), A, brow, t + 3);
    BAR; WAIT_A(At); MMA1(0, At, B0); BAR; SCHED;
    STAGEB(SB(1, 1), Bt, bcol + HALF, t + 3);
    WAIT_V(6); BAR; MMA1(1, At, B1); BAR;
  }
  { LDB(B0, 0, 0); LDA(At, 0, 0); STAGEA(SA(1, 1), A, brow + HALF, nt - 1);
    BAR; WAIT_AB(At, B0); MMA(0, 0, At, B0); BAR;
    LDB(B1, 0, 1); BAR; WAIT_B(B1); MMA(0, 1, At, B1); BAR;
    LDA(At, 0, 1); WAIT_V(4); BAR; WAIT_A(At); MMA1(0, At, B0); MMA1(1, At, B1); BAR; }
  { LDB(B0, 1, 0); LDA(At, 1, 0); WAIT_V(2); BAR; WAIT_AB(At, B0); MMA(0, 0, At, B0); BAR;
    LDB(B1, 1, 1); WAIT_V(0); BAR; WAIT_B(B1); MMA(0, 1, At, B1); BAR;
    LDA(At, 1, 1); BAR; WAIT_A(At); MMA1(0, At, B0); MMA1(1, At, B1); BAR; }
  if (wr == 0) BAR;
#undef SA
#undef SB
#undef STAGE_
#undef STAGEA
#undef STAGEB
#undef LDA
#undef DSR
#undef LDB
#undef MMA
#undef MMA1
#undef WAIT_V
#undef WAIT_L8
#undef WAIT_A
#undef WAIT_B
#undef WAIT_AB
#undef BAR
#undef SCHED
}
DI void kstage4(const PX& p, const bfu* __restrict__ A, const bfu* __restrict__ Bt, const int K, const int brow, const int bcol, bfu* shm) {
  constexpr int HALF = 128, HT = HALF * 64;
  int tid_ = TIDX(p); OPAQUE(tid_);
  const int tid = tid_;
  const int wvb_ = p.wv * 1024;
  unsigned oa0, oa1, obb0, obb1;
  { int r_, c_;
    stage_rc(tid * 16, r_, c_); oa0 = (unsigned)(r_ * K + c_) * 2u;
    { const int rho = r_ & 31, pr = (r_ & ~31) + 8 * ((rho & 15) >> 2) + 4 * (rho >> 4) + (rho & 3); obb0 = (unsigned)(pr * K + c_) * 2u; }
    stage_rc(tid * 16 + 8192, r_, c_); oa1 = (unsigned)(r_ * K + c_) * 2u;
    { const int rho = r_ & 31, pr = (r_ & ~31) + 8 * ((rho & 15) >> 2) + 4 * (rho >> 4) + (rho & 3); obb1 = (unsigned)(pr * K + c_) * 2u; } }
#define KS_(Pp, BASE, br, O0, O1)                                                                          \
  do {                                                                                                     \
    const char* _g = (const char*)(BASE + (long)(br) * K);                                                 \
    __builtin_amdgcn_global_load_lds((const unsigned*)(_g + O0), (LDS3 unsigned*)((char*)(Pp) + wvb_), 16, 0, 0); \
    __builtin_amdgcn_global_load_lds((const unsigned*)(_g + O1), (LDS3 unsigned*)((char*)(Pp) + wvb_ + 8192), 16, 0, 0); \
  } while (0)
  KS_(shm + 4 * HT, Bt, bcol, obb0, obb1);
  KS_(shm + 0 * HT, A, brow, oa0, oa1);
  KS_(shm + 5 * HT, Bt, bcol + HALF, obb0, obb1);
  KS_(shm + 1 * HT, A, brow + HALF, oa0, oa1);
#undef KS_
}
DI void tile_of(int L, int nM, int nN, int& pm, int& pn) {
  const int nwg = nM * nN;
  int wgid = L;
  { const int q = nwg / 8, r = nwg % 8, xcd = wgid % 8, off = wgid / 8;
    wgid = (xcd < r ? xcd * (q + 1) : r * (q + 1) + (xcd - r) * q) + off; }
  const int nig = 8 * nN, gid = wgid / nig, fm = gid * 8, gsz = min(nM - fm, 8);
  pm = fm + ((wgid % nig) % gsz);
  pn = (wgid % nig) / gsz;
}

enum { EPI_INPROJ = 0, EPI_GLU = 1, EPI_RES = 2, EPI_FF1 = 3, EPI_GATE = 4, EPI_MERGE = 5 };

template <int EPI, int HM>
DI void epi256(const PX& p, int l, f32x4 (&acc)[2][2][4][2], int brow, int bcol, int aux, bool src_input) {
  int tid_ = TIDX(p); OPAQUE(tid_);
  const int wid = tid_ >> 6, lane = tid_ & 63, wr = wid >> 2, wc = wid & 3, fr = lane & 15, fq = lane >> 4;
  f32x4 hg[2][2], hlg[2][2], hlb[2][2];
  if (EPI == EPI_RES) {
    const int mbt = modrow(brow);
#pragma unroll
    for (int bj = 0; bj < 2; bj++) {
      const int c0 = bcol + bj * 128 + wc * 32 + fq * 8;
      const float* gp = mods(p, l, mbt, aux) + c0;
      hg[bj][0] = *(const f32x4*)gp; hg[bj][1] = *(const f32x4*)(gp + 4);
      const int ll = (aux == 5) ? l : (l > 0 ? l - 1 : 0);
      const float* lg = p.in[aux == 5 ? 35 : 37] + ll * 2048 + c0;
      const float* lb = p.in[aux == 5 ? 36 : 38] + ll * 2048 + c0;
      hlg[bj][0] = *(const f32x4*)lg; hlg[bj][1] = *(const f32x4*)(lg + 4);
      hlb[bj][0] = *(const f32x4*)lb; hlb[bj][1] = *(const f32x4*)(lb + 4);
    }
  }
#pragma unroll
  for (int ai = 0; ai < (HM ? 1 : 2); ai++)
#pragma unroll
    for (int bj = 0; bj < 2; bj++)
#pragma unroll
      for (int m = 0; m < 4; m++) {
          const int row = brow + ai * 128 + wr * 64 + m * 16 + fr;
          const int col0 = bcol + bj * 128 + wc * 32 + fq * 8;
          const f32x4 va = acc[ai][bj][m][0], vb = acc[ai][bj][m][1];
          const float v[8] = {va[0], va[1], va[2], va[3], vb[0], vb[1], vb[2], vb[3]};
          if (EPI == EPI_INPROJ) {
            if (col0 < 2304) {
              const bool odd = (fr & 1) != 0;
              bfu* d = wsb(p, OFF_BIG + B_ZHY) + (size_t)(col0 + (odd ? 4 : 0)) * NTOK + (row & ~1);
#pragma unroll
              for (int j = 0; j < 4; j++) {
                const float snd = odd ? v[j] : v[4 + j];
                const float rcv = __shfl_xor(snd, 1);
                const unsigned pr = odd ? pack2(rcv, v[4 + j]) : pack2(v[j], rcv);
                *(unsigned*)(d + (size_t)j * NTOK) = pr;
              }
            } else if (col0 < 5376) {
              uint4 o; o.x = pack2(v[0], v[1]); o.y = pack2(v[2], v[3]); o.z = pack2(v[4], v[5]); o.w = pack2(v[6], v[7]);
              *(uint4*)(wsb(p, OFF_BIG + B_ZML) + (size_t)row * 3072 + (col0 - 2304)) = o;
            } else {
              uint4 o; o.x = pack2(v[0], v[1]); o.y = pack2(v[2], v[3]); o.z = pack2(v[4], v[5]); o.w = pack2(v[6], v[7]);
              *(uint4*)(wsb(p, OFF_BIG + B_ZU) + (size_t)row * 768 + (col0 - 5376)) = o;
            }
          } else if (EPI == EPI_GLU) {
            const float* gbp = p.in[30] + l * 768 + col0;
            const f32x4 g0 = *(const f32x4*)gbp, g1 = *(const f32x4*)(gbp + 4);
            const float gb[8] = {g0[0], g0[1], g0[2], g0[3], g1[0], g1[1], g1[2], g1[3]};
            const uint4 z = *(const uint4*)(wsb(p, OFF_BIG + B_YF) + (size_t)row * 768 + col0);
            const unsigned zz[4] = {z.x, z.y, z.z, z.w};
            unsigned oo[4];
#pragma unroll
            for (int q = 0; q < 4; q++)
              oo[q] = pack2(lo16(zz[q]) * sigmoidf_(v[2 * q] + gb[2 * q]), hi16(zz[q]) * sigmoidf_(v[2 * q + 1] + gb[2 * q + 1]));
            *(uint4*)(wsb(p, OFF_BIG + B_YB) + (size_t)row * 768 + col0) = make_uint4(oo[0], oo[1], oo[2], oo[3]);
          } else if (EPI == EPI_RES) {
            const float* xp = (src_input ? input_row(p, row) : (const float*)stream_row(p, row)) + col0;
            const f32x4 g0 = hg[bj][0], g1 = hg[bj][1];
            f32x4 x0 = *(const f32x4*)xp, x1 = *(const f32x4*)(xp + 4);
            if (!src_input) {
              const float2 st = *(const float2*)(wsf(p, OFF_STATS) + ((size_t)(aux == 5 ? 0 : 1) * NTOK + row) * 2);
              const f32x4 lg0 = hlg[bj][0], lg1 = hlg[bj][1];
              const f32x4 lb0 = hlb[bj][0], lb1 = hlb[bj][1];
#pragma unroll
              for (int j = 0; j < 4; j++) {
                x0[j] = (x0[j] - st.x) * st.y * lg0[j] + lb0[j];
                x1[j] = (x1[j] - st.x) * st.y * lg1[j] + lb1[j];
              }
            }
            f32x4 o0, o1;
#pragma unroll
            for (int j = 0; j < 4; j++) { o0[j] = ALPHA * x0[j] + g0[j] * va[j]; o1[j] = ALPHA * x1[j] + g1[j] * vb[j]; }
            float* dp = stream_row(p, row) + col0;
            *(f32x4*)dp = o0;
            *(f32x4*)(dp + 4) = o1;
          } else if (EPI == EPI_FF1) {
            float t[8];
#pragma unroll
            for (int j = 0; j < 8; j++) { t[j] = fmaxf(v[j], 0.f); t[j] *= t[j]; }
            uint4 o; o.x = pack2(t[0], t[1]); o.y = pack2(t[2], t[3]); o.z = pack2(t[4], t[5]); o.w = pack2(t[6], t[7]);
            *(uint4*)(wsb(p, OFF_BIG) + (size_t)row * 8192 + col0) = o;
          } else if (EPI == EPI_GATE) {
            uint4 o;
            o.x = pack2(sigmoidf_(v[0]), sigmoidf_(v[1])); o.y = pack2(sigmoidf_(v[2]), sigmoidf_(v[3]));
            o.z = pack2(sigmoidf_(v[4]), sigmoidf_(v[5])); o.w = pack2(sigmoidf_(v[6]), sigmoidf_(v[7]));
            *(uint4*)(wsb(p, OFF_BIG + B_ZML) + (size_t)row * 2048 + col0) = o;
          } else if (EPI == EPI_MERGE) {
            const uint4 g = *(const uint4*)(wsb(p, OFF_BIG + B_ZML) + (size_t)row * 2048 + col0);
            uint4* d = (uint4*)(wsb(p, OFF_BIG + B_ZHY) + (size_t)row * 2048 + col0);
            uint4 old = make_uint4(0u, 0u, 0u, 0u);
            if (aux) old = *d;
            const unsigned gg[4] = {g.x, g.y, g.z, g.w}, od[4] = {old.x, old.y, old.z, old.w};
            unsigned oo[4];
#pragma unroll
            for (int q = 0; q < 4; q++)
              oo[q] = pack2(lo16(od[q]) + lo16(gg[q]) * v[2 * q], hi16(od[q]) + hi16(gg[q]) * v[2 * q + 1]);
            *d = make_uint4(oo[0], oo[1], oo[2], oo[3]);
          }
        }
}

template <int EPI>
DI void gemm_phase(const PX& p, int l, const bfu* A, const bfu* Bt, int K, int M, int nN, int aux, bool src_input,
                   unsigned char* smem, int Mh = 0) {
  const int nM = M >> 8;
  const int nF = nM * nN, nHm = Mh >> 7;
  const int total = nF + nHm * nN;
  constexpr bool EARLY = (EPI == EPI_FF1 || EPI == EPI_INPROJ);
  int L = blockIdx.x;
  if (L >= total) return;
  int brow, bcol;
  bool half;
  if (L < nF) { int pm, pn; tile_of(L, nM, nN, pm, pn); brow = pm * 256; bcol = pn * 256; half = false; }
  else { const int Lh = L - nF; brow = M + (Lh & 31) * 128; bcol = (Lh >> 5) * 256; half = true; }
  if (EARLY) kstage4(p, A, Bt, K, brow, bcol, (bfu*)smem);
  while (true) {
    const int Ln = L + gridDim.x;
    const bool has = Ln < total;
    int nbrow = 0, nbcol = 0;
    bool nhalf = false;
    if (has) {
      if (Ln < nF) { int pm, pn; tile_of(Ln, nM, nN, pm, pn); nbrow = pm * 256; nbcol = pn * 256; }
      else { const int Lh = Ln - nF; nbrow = M + (Lh & 31) * 128; nbcol = (Lh >> 5) * 256; nhalf = true; }
    }
    if (!half) {
      f32x4 acc[2][2][4][2];
      kloop256<0>(p, acc, A, Bt, K, brow, bcol, (bfu*)smem, EARLY);
      if (EARLY && has) kstage4(p, A, Bt, K, nbrow, nbcol, (bfu*)smem);
      epi256<EPI, 0>(p, l, acc, brow, bcol, aux, src_input);
    } else {
      f32x4 acc[2][2][4][2];
      kloop256<1>(p, acc, A, Bt, K, brow, bcol, (bfu*)smem, EARLY);
      if (EARLY && has) kstage4(p, A, Bt, K, nbrow, nbcol, (bfu*)smem);
      epi256<EPI, 1>(p, l, acc, brow, bcol, aux, src_input);
    }
    if (!has) break;
    L = Ln; brow = nbrow; bcol = nbcol; half = nhalf;
  }
}

template <int HM>
DI void merge_tile(const PX& p, int brow, int bcol, unsigned char* smem) {
  const bfu* hA = wsb(p, OFF_H);
  const bfu* W1 = wsb(p, OFF_W1);
#pragma unroll 1
  for (int br = 0; br < 3; br++) {
    {
      f32x4 acc[2][2][4][2];
      kloop256<HM>(p, acc, hA, W1 + W1_WIN + (size_t)(6160 + br * 2048) * 2048, 2048, brow, bcol, (bfu*)smem);
      epi256<EPI_GATE, HM>(p, 0, acc, brow, bcol, 0, false);
    }
    {
      f32x4 acc[2][2][4][2];
      const bfu* Y = wsb(p, OFF_BIG + (br == 0 ? B_YHY : (br == 1 ? B_HF : B_YB)));
      const bfu* Wo = W1 + (br == 0 ? W1_WHY : (br == 1 ? W1_WML : W1_WS5));
      kloop256<HM>(p, acc, Y, Wo, 768, brow, bcol, (bfu*)smem);
      epi256<EPI_MERGE, HM>(p, 0, acc, brow, bcol, br, false);
    }
  }
}
DI void merge_phase(const PX& p, int M, unsigned char* smem, int Mh = 0) {
  const int nM = M >> 8;
  const int nF = nM * 8, nHm = Mh >> 7;
  for (int L = blockIdx.x; L < nF + nHm * 8; L += gridDim.x) {
    if (L < nF) {
      int pm, pn;
      tile_of(L, nM, 8, pm, pn);
      merge_tile<0>(p, pm * 256, pn * 256, smem);
    } else {
      const int Lh = L - nF, pmh = Lh & 31, pn = Lh >> 5;
      merge_tile<1>(p, M + pmh * 128, pn * 256, smem);
    }
  }
}

DI void gate_gemm(const PX& p, int wgi, int nwg) {
  int tid_ = TIDX(p); OPAQUE(tid_);
  const int lane = tid_ & 63, w = tid_ >> 6, fr = lane & 15, kq = lane >> 4;
  const bfu* hA = wsb(p, OFF_H);
  const bfu* Wg = wsb(p, OFF_W1) + W1_WIN + (size_t)6144 * 2048 + (size_t)fr * 2048 + 8 * kq;
  float* Zgt = wsf(p, OFF_BIG + B_ZGT);
  for (int rb = wgi * 8 + w; rb < NTOK / 16; rb += nwg * 8) {
    const bfu* ap = hA + (size_t)(rb * 16 + fr) * 2048 + 8 * kq;
    f32x4 acc = f32x4{0.f, 0.f, 0.f, 0.f};
#pragma unroll 8
    for (int ks = 0; ks < 64; ks++) {
      const bf16x8 a = *(const bf16x8*)(ap + 32 * ks);
      const bf16x8 b = *(const bf16x8*)(Wg + 32 * ks);
      acc = mfma16(a, b, acc);
    }
#pragma unroll
    for (int j = 0; j < 4; j++) Zgt[(size_t)(rb * 16 + 4 * kq + j) * 16 + fr] = acc[j];
  }
}

DI void mod_partial(const PX& p, int it, float* sm) {
  int tid_ = TIDX(p); OPAQUE(tid_); const int tid = tid_;
  const int nb = it % 6, ks = (it / 6) % 32, l = it / 192;
  __syncthreads();
  for (int idx = tid; idx < 17 * 64; idx += NTHR) {
    const int j = idx >> 6, kk = idx & 63, k = ks * 64 + kk;
    const float c = j < 16 ? p.in[1][j * 2048 + k] : p.in[3][k];
    sm[idx] = c / (1.f + __expf(-c));
  }
  __syncthreads();
  float4 acc[17];
#pragma unroll
  for (int j = 0; j < 17; j++) acc[j] = make_float4(0.f, 0.f, 0.f, 0.f);
  const int n = nb * 2048 + tid * 4;
  const float* wp = p.in[4] + ((size_t)l * 2048 + ks * 64) * 12288 + n;
#pragma unroll 4
  for (int kk = 0; kk < 64; kk++) {
    const float4 wv = *(const float4*)(wp + (size_t)kk * 12288);
#pragma unroll
    for (int j = 0; j < 17; j++) {
      const float s = sm[j * 64 + kk];
      acc[j].x += s * wv.x; acc[j].y += s * wv.y; acc[j].z += s * wv.z; acc[j].w += s * wv.w;
    }
  }
  float* part = wsf(p, OFF_BIG) + ((size_t)(l * 32 + ks) * 17) * 12288 + n;
#pragma unroll
  for (int j = 0; j < 17; j++) *(float4*)(part + (size_t)j * 12288) = acc[j];
}

DI void cvt_tile(const PX& p, const float* __restrict__ src, bfu* __restrict__ dst, int K, int N, int tile, float* t, bool perm_in = false) {
  const int ntn = (N + 63) >> 6;
  const int kt = tile / ntn, nt = tile - kt * ntn;
  const int k0 = kt * 64, n0 = nt * 64;
  int tidc = TIDX(p); OPAQUE(tidc);
  __syncthreads();
#pragma unroll
  for (int i = 0; i < 2; i++) {
    const int idx = tidc + i * NTHR;
    const int kk = idx >> 4, n4 = (idx & 15) * 4, n = n0 + n4;
    float4 v = make_float4(0.f, 0.f, 0.f, 0.f);
    if (n < N) v = *(const float4*)(src + (size_t)(k0 + kk) * N + n);
    t[kk * 65 + n4] = v.x; t[kk * 65 + n4 + 1] = v.y; t[kk * 65 + n4 + 2] = v.z; t[kk * 65 + n4 + 3] = v.w;
  }
  __syncthreads();
  {
    const int nn = tidc >> 3, k8 = (tidc & 7) * 8, n = n0 + nn;
    if (n < N) {
      uint4 o;
      o.x = pack2(t[(k8 + 0) * 65 + nn], t[(k8 + 1) * 65 + nn]);
      o.y = pack2(t[(k8 + 2) * 65 + nn], t[(k8 + 3) * 65 + nn]);
      o.z = pack2(t[(k8 + 4) * 65 + nn], t[(k8 + 5) * 65 + nn]);
      o.w = pack2(t[(k8 + 6) * 65 + nn], t[(k8 + 7) * 65 + nn]);
      const int dn = (!perm_in || n < 5376 || n >= 6160) ? n : (n < 5392 ? n + 768 : n - 16);
      *(uint4*)(dst + (size_t)dn * K + k0 + k8) = o;
    }
  }
}
#define MIX_TILES 8496
DI void convert_mixer(const PX& p, int l, int tile, float* sm) {
  bfu* W1 = wsb(p, OFF_W1);
  if (tile < 6176) cvt_tile(p, p.in[6] + (size_t)l * 2048 * NIN, W1 + W1_WIN, 2048, NIN, tile, sm, true);
  else if (tile < 7200) cvt_tile(p, p.in[34] + (size_t)l * 2048 * 2048, W1 + W1_WOUT, 2048, 2048, tile - 6176, sm);
  else if (tile < 7584) cvt_tile(p, p.in[31] + (size_t)l * 768 * 2048, W1 + W1_WHY, 768, 2048, tile - 7200, sm);
  else if (tile < 7968) cvt_tile(p, p.in[32] + (size_t)l * 768 * 2048, W1 + W1_WML, 768, 2048, tile - 7584, sm);
  else if (tile < 8352) cvt_tile(p, p.in[33] + (size_t)l * 768 * 2048, W1 + W1_WS5, 768, 2048, tile - 7968, sm);
  else cvt_tile(p, p.in[29] + (size_t)l * 768 * 768, W1 + W1_GLU, 768, 768, tile - 8352, sm);
}
#define FFN_TILES 8192
DI void convert_ffn(const PX& p, int l, int tile, float* sm) {
  bfu* W2 = wsb(p, OFF_BIG + B_W2);
  if (tile < 4096) cvt_tile(p, p.in[39] + (size_t)l * 2048 * 8192, W2, 2048, 8192, tile, sm);
  else cvt_tile(p, p.in[40] + (size_t)l * 8192 * 2048, W2 + (size_t)8192 * 2048, 8192, 2048, tile - 4096, sm);
}

#define N_FILT_ITEMS 544
DI void filter_item(const PX& p, int it, float* sm) {
  int tid_ = TIDX(p); OPAQUE(tid_); const int tid = tid_;
  int l, L, j0;
  bfu* R;
  if (it < 256) { l = 0; L = 2048; j0 = it * 8; R = (bfu*)(p.ws + OFF_FILT); }
  else if (it < 512) { l = 1; L = 2048; j0 = (it - 256) * 8; R = (bfu*)(p.ws + OFF_FILT + FILT_L); }
  else { l = 0; L = 256; j0 = (it - 512) * 8; R = (bfu*)(p.ws + OFF_FILT + 2 * FILT_L); }
  float* feats = sm;
  float* h1 = sm + 320;
  float* h2 = sm + 320 + 512;
  const int lg = tid >> 6, i = tid & 63;
  const int j = j0 + lg;
  const float tj = (float)j / (float)(L - 1);
  __syncthreads();
  if (i < 33) {
    float f;
    if (i == 0) f = tj;
    else {
      const int bi = (i - 1) & 15;
      float bstep = 0.99999333333f, w0 = (L == 2048) ? 0.0030679615757712823f : 0.02454369260617026f;
      OPAQUE(bstep); OPAQUE(w0);
      const float band = 1e-4f + (float)bi * bstep;
      const float a = w0 * (float)j;
      const float ang = a * band;
      float sn, cs; sincos_f(ang, sn, cs);
      f = (i <= 16) ? cs : sn;
    }
    feats[lg * 40 + i] = f;
  }
  __syncthreads();
  const float fr = p.in[14][l * 64 + i];
  {
    float s = p.in[10][l * 64 + i];
    const float* w1 = p.in[9] + (size_t)l * 33 * 64;
#pragma unroll 11
    for (int f = 0; f < 33; f++) s += feats[lg * 40 + f] * w1[f * 64 + i];
    h1[lg * 64 + i] = sin_f(fr * s);
  }
  __syncthreads();
  {
    float s = p.in[12][l * 64 + i];
    const float* w2 = p.in[11] + (size_t)l * 64 * 64;
#pragma unroll 16
    for (int k = 0; k < 64; k++) s += h1[lg * 64 + k] * w2[k * 64 + i];
    h2[lg * 64 + i] = sin_f(fr * s);
  }
  __syncthreads();
  const float* w3 = p.in[13] + (size_t)l * 64 * 3072;
  float sacc[6][8];
#pragma unroll
  for (int q6 = 0; q6 < 6; q6++)
#pragma unroll
    for (int q = 0; q < 8; q++) sacc[q6][q] = 0.f;
#pragma unroll 4
  for (int k = 0; k < 64; k++) {
    float wv[6];
#pragma unroll
    for (int q6 = 0; q6 < 6; q6++) wv[q6] = w3[k * 3072 + tid + NTHR * q6];
#pragma unroll
    for (int q = 0; q < 8; q++) {
      const float hv = h2[q * 64 + k];
#pragma unroll
      for (int q6 = 0; q6 < 6; q6++) sacc[q6][q] += hv * wv[q6];
    }
  }
#pragma unroll
  for (int q6 = 0; q6 < 6; q6++) {
    const int n = tid + NTHR * q6;
    const int o = n / 1536, dir = (n % 1536) / 768, c = n % 768;
    const float dc = fabsf(p.in[15][(l * 2 + o) * 768 + c]);
    bfu* Rc = R + (size_t)(o * 768 + c) * (2 * L);
#pragma unroll
    for (int q = 0; q < 8; q++) {
      const int jj = j0 + q;
      const float tq = (float)jj / (float)(L - 1);
      const float val = sacc[q6][q] * expf(-tq * dc);
      if (dir == 0) Rc[L - jj] = f2bf(val);
      else if (jj > 0) Rc[L + jj] = f2bf(val);
    }
  }
}

DI void phase0(const PX& p, unsigned char* smem) {
  float* sm = (float*)smem;
  if (blockIdx.x == 0 && TIDX(p) < 64) ((unsigned*)(p.ws + OFF_CNT))[TIDX(p)] = 0u;
  const int n_mod = 384;
  const int total = n_mod + MIX_TILES + N_FILT_ITEMS;
  for (int it = blockIdx.x; it < total; it += gridDim.x) {
    if (it < n_mod) { if (EN & 256) mod_partial(p, it, sm); }
    else if (it < n_mod + N_FILT_ITEMS) { if (EN & 512) filter_item(p, it - n_mod, sm); }
    else convert_mixer(p, 0, it - n_mod - N_FILT_ITEMS, sm);
  }
}

DI void phase1(const PX& p) {
  const int total = 2 * 17 * 3072;
  int tx = TIDX(p); OPAQUE(tx);
  for (int u = blockIdx.x * NTHR + tx; u < total; u += gridDim.x * NTHR) {
    const int n = (u % 3072) * 4, j = (u / 3072) % 17, l = u / (3072 * 17);
    float4 s = *(const float4*)(p.in[5] + l * 12288 + n);
    for (int ks = 0; ks < 32; ks++) {
      const float4 v = *(const float4*)(wsf(p, OFF_BIG) + ((size_t)(l * 32 + ks) * 17 + j) * 12288 + n);
      s.x += v.x; s.y += v.y; s.z += v.z; s.w += v.w;
    }
    *(float4*)(wsf(p, OFF_MOD) + (size_t)(l * 17 + j) * 12288 + n) = s;
  }
}

DI void phase2(const PX& p) {
  int tid_ = TIDX(p); OPAQUE(tid_);
  const int lane = tid_ & 63;
  const int wg = blockIdx.x * 8 + (tid_ >> 6), nw = gridDim.x * 8;
  bfu* hA = wsb(p, OFF_H);
  const int rpw = (NTOK + nw - 1) / nw;
  float4 sa[8], sb[8];
#pragma unroll
  for (int i = 0; i < 8; i++) { sa[i] = make_float4(0.f, 0.f, 0.f, 0.f); sb[i] = make_float4(0.f, 0.f, 0.f, 0.f); }
  int mb_cur = -1;
  for (int k = 0; k < rpw; k++) {
    const int r = wg * rpw + k;
    if (r >= NTOK) break;
    const float* x = input_row(p, r);
    float4 v[8];
#pragma unroll
    for (int i = 0; i < 8; i++) v[i] = *(const float4*)(x + lane * 4 + 256 * i);
    const int mb = modrow(r);
    if (mb != mb_cur) {
      mb_cur = mb;
      const float* sh = mods(p, 0, mb, 0);
      const float* sc = mods(p, 0, mb, 1);
#pragma unroll
      for (int i = 0; i < 8; i++) {
        sa[i] = *(const float4*)(sh + lane * 4 + 256 * i);
        sb[i] = *(const float4*)(sc + lane * 4 + 256 * i);
      }
    }
#pragma unroll
    for (int i = 0; i < 8; i++) {
      const int c = lane * 4 + 256 * i;
      uint2 o;
      o.x = pack2(v[i].x * (1.f + sb[i].x) + sa[i].x, v[i].y * (1.f + sb[i].y) + sa[i].y);
      o.y = pack2(v[i].z * (1.f + sb[i].z) + sa[i].z, v[i].w * (1.f + sb[i].w) + sa[i].w);
      *(uint2*)(hA + (size_t)r * 2048 + c) = o;
    }
  }
}

DI void ln_pass(const PX& p, int l, int which, int M) {
  int tid_ = TIDX(p); OPAQUE(tid_);
  const int lane = tid_ & 63;
  const int wg = blockIdx.x * 8 + (tid_ >> 6), nw = gridDim.x * 8;
  const float* g = p.in[which ? 37 : 35] + l * 2048;
  const float* bta = p.in[which ? 38 : 36] + l * 2048;
  const bool emit = (which == 0) || (l + 1 < 2);
  const bool writex = (which == 1) && (l + 1 >= 2);
  float* stats = wsf(p, OFF_STATS) + (size_t)which * NTOK * 2;
  const int ml = which ? l + 1 : l;
  const int ch_sh = which ? 0 : 3, ch_sc = which ? 1 : 4;
  bfu* hA = wsb(p, OFF_H);
  const int rpw = (M + nw - 1) / nw;
  float4 gg[8], bb[8], sa[8], sb[8];
#pragma unroll
  for (int i = 0; i < 8; i++) {
    gg[i] = *(const float4*)(g + lane * 4 + 256 * i);
    bb[i] = *(const float4*)(bta + lane * 4 + 256 * i);
    sa[i] = make_float4(0.f, 0.f, 0.f, 0.f);
    sb[i] = make_float4(0.f, 0.f, 0.f, 0.f);
  }
  int mb_cur = -1;
  for (int k = 0; k < rpw; k++) {
    const int r = wg * rpw + k;
    if (r >= M) break;
    float* x = stream_row(p, r);
    float4 v[8];
    float s = 0.f;
#pragma unroll
    for (int i = 0; i < 8; i++) {
      v[i] = *(const float4*)(x + lane * 4 + 256 * i);
      s += v[i].x + v[i].y + v[i].z + v[i].w;
    }
    const int mb = modrow(r);
    if (emit && mb != mb_cur) {
      mb_cur = mb;
      const float* sh = mods(p, ml, mb, ch_sh);
      const float* sc = mods(p, ml, mb, ch_sc);
#pragma unroll
      for (int i = 0; i < 8; i++) {
        sa[i] = *(const float4*)(sh + lane * 4 + 256 * i);
        sb[i] = *(const float4*)(sc + lane * 4 + 256 * i);
      }
    }
    const float mu = wave_sum(s) * (1.f / 2048.f);
    float q = 0.f;
#pragma unroll
    for (int i = 0; i < 8; i++) {
      v[i].x -= mu; v[i].y -= mu; v[i].z -= mu; v[i].w -= mu;
      q += v[i].x * v[i].x + v[i].y * v[i].y + v[i].z * v[i].z + v[i].w * v[i].w;
    }
    const float rs = rsqrtf(wave_sum(q) * (1.f / 2048.f) + 1e-5f);
    if (!writex && lane == 0) *(float2*)(stats + (size_t)r * 2) = make_float2(mu, rs);
#pragma unroll
    for (int i = 0; i < 8; i++) {
      const int c = lane * 4 + 256 * i;
      float4 y;
      y.x = v[i].x * rs * gg[i].x + bb[i].x; y.y = v[i].y * rs * gg[i].y + bb[i].y;
      y.z = v[i].z * rs * gg[i].z + bb[i].z; y.w = v[i].w * rs * gg[i].w + bb[i].w;
      if (writex) *(float4*)(x + c) = y;
      if (emit) {
        uint2 o;
        o.x = pack2(y.x * (1.f + sb[i].x) + sa[i].x, y.y * (1.f + sb[i].y) + sa[i].y);
        o.y = pack2(y.z * (1.f + sb[i].z) + sa[i].z, y.w * (1.f + sb[i].w) + sa[i].w);
        *(uint2*)(hA + (size_t)r * 2048 + c) = o;
      }
    }
  }
}

DI void post_scan(const PX& p, int l, int M, unsigned char* smem) {
  {
    bfu* tl = (bfu*)smem;
    int tx = TIDX(p); OPAQUE(tx);
    const bfu* Zt = wsb(p, OFF_BIG + B_ZHY);
    bfu* Yh = wsb(p, OFF_BIG + B_YHY);
    const int nt = (M >> 6) * 12;
    for (int it = blockIdx.x; it < nt; it += gridDim.x) {
      const int r0 = (it / 12) * 64, c0 = (it % 12) * 64;
      __syncthreads();
#pragma unroll
      for (int i = 0; i < 8; i++) {
        const int idx = tx + i * NTHR, ci = idx >> 6, ti = idx & 63;
        tl[ci * 66 + ti] = Zt[(size_t)(c0 + ci) * NTOK + r0 + ti];
      }
      __syncthreads();
#pragma unroll
      for (int i = 0; i < 8; i++) {
        const int idx = tx + i * NTHR, ti = idx >> 6, ci = idx & 63;
        Yh[(size_t)(r0 + ti) * 768 + c0 + ci] = tl[ci * 66 + ti];
      }
    }
  }
  int tid_ = TIDX(p); OPAQUE(tid_);
  const int lane = tid_ & 63;
  const int wg = blockIdx.x * 8 + (tid_ >> 6), nw = gridDim.x * 8;
  bfu* Hf = wsb(p, OFF_BIG + B_HF);
  const bfu* Hb = wsb(p, OFF_BIG + B_HB);
  const bfu* Zml = wsb(p, OFF_BIG + B_ZML);
  bfu* Yf = wsb(p, OFF_BIG + B_YF);
  const bfu* Yb = wsb(p, OFF_BIG + B_YB);
  const bfu* Zu = wsb(p, OFF_BIG + B_ZU);
  const float* ng = p.in[20] + l * 768;
  const float* sd = p.in[28] + l * 768;
  float4 ngv[3], sdv[3];
#pragma unroll
  for (int i = 0; i < 3; i++) { ngv[i] = *(const float4*)(ng + lane * 12 + 4 * i); sdv[i] = *(const float4*)(sd + lane * 12 + 4 * i); }
  for (int r = wg; r < M; r += nw) {
    const size_t ro = (size_t)r * 768 + lane * 12;
    {
      float x[12];
      const uint2* hf = (const uint2*)(Hf + ro);
      const uint2* hb = (const uint2*)(Hb + ro);
      float s = 0.f;
#pragma unroll
      for (int i = 0; i < 3; i++) {
        const uint2 a = hf[i], bq = hb[i];
        x[4 * i] = lo16(a.x) + lo16(bq.x); x[4 * i + 1] = hi16(a.x) + hi16(bq.x);
        x[4 * i + 2] = lo16(a.y) + lo16(bq.y); x[4 * i + 3] = hi16(a.y) + hi16(bq.y);
        s += x[4 * i] + x[4 * i + 1] + x[4 * i + 2] + x[4 * i + 3];
      }
#pragma unroll
      for (int o = 8; o >= 1; o >>= 1) s += __shfl_xor(s, o);
      const float mu = s * (1.f / 192.f);
      float q = 0.f;
#pragma unroll
      for (int i = 0; i < 12; i++) { x[i] -= mu; q += x[i] * x[i]; }
#pragma unroll
      for (int o = 8; o >= 1; o >>= 1) q += __shfl_xor(q, o);
      const float rs = rsqrtf(q * (1.f / 192.f) + 1e-5f);
      const uint2* og = (const uint2*)(Zml + (size_t)r * 3072 + 2304 + lane * 12);
      const float4* gg = (const float4*)(ng + lane * 12);
#pragma unroll
      for (int i = 0; i < 3; i++) {
        const uint2 o = og[i];
        const float4 g4 = ngv[i];
        uint2 w_;
        w_.x = pack2(x[4 * i] * rs * g4.x * sigmoidf_(lo16(o.x)), x[4 * i + 1] * rs * g4.y * sigmoidf_(hi16(o.x)));
        w_.y = pack2(x[4 * i + 2] * rs * g4.z * sigmoidf_(lo16(o.y)), x[4 * i + 3] * rs * g4.w * sigmoidf_(hi16(o.y)));
        ((uint2*)(Hf + ro))[i] = w_;
      }
    }
    {
      const uint2* yf = (const uint2*)(Yf + ro);
      const uint2* yb = (const uint2*)(Yb + ro);
      const uint2* zu = (const uint2*)(Zu + ro);
      const float4* dd = (const float4*)(sd + lane * 12);
#pragma unroll
      for (int i = 0; i < 3; i++) {
        const uint2 a = yf[i], bq = yb[i], u = zu[i];
        const float4 d4 = sdv[i];
        float y[4];
        y[0] = lo16(a.x) + lo16(bq.x) + d4.x * lo16(u.x);
        y[1] = hi16(a.x) + hi16(bq.x) + d4.y * hi16(u.x);
        y[2] = lo16(a.y) + lo16(bq.y) + d4.z * lo16(u.y);
        y[3] = hi16(a.y) + hi16(bq.y) + d4.w * hi16(u.y);
#pragma unroll
        for (int j = 0; j < 4; j++) {
          const float uu = 0.7978845608028654f * (y[j] + 0.044715f * y[j] * y[j] * y[j]);
          y[j] = 0.5f * y[j] * (1.f + tanhf(uu));
        }
        uint2 w_;
        w_.x = pack2(y[0], y[1]); w_.y = pack2(y[2], y[3]);
        ((uint2*)(Yf + ro))[i] = w_;
      }
    }
  }
}

DI void s5_job(const PX& p, int l, int job, unsigned char* smem) {
  int tid_ = TIDX(p); OPAQUE(tid_); const int tid = tid_, lane = tid & 63, w = tid >> 6;
  const bool active = w < 4;
  const int cl = (w >> 1) & 1, hf = w & 1;
  const int chain = job * 2 + cl;
  const int g = chain >> 1, dir = chain & 1;
  const int b = lane & 15, kq = lane >> 4;
  const int pg = (l * 2 + dir) * 48 + g;
  const float* a_re = p.in[21] + (size_t)pg * 64;
  const float* a_im = p.in[22] + (size_t)pg * 64;
  const float dt = expf(p.in[23][pg]);
  const float* b_re = p.in[24] + (size_t)pg * 1024;
  const float* b_im = p.in[25] + (size_t)pg * 1024;
  const float* c_re = p.in[26] + (size_t)pg * 1024;
  const float* c_im = p.in[27] + (size_t)pg * 1024;
  float* ex = (float*)smem + cl * (2 * 32 * 64);
  bf16x8 Are[2], Aim[2], Cf[2];
  float lre[2][4], lim[2][4];
#pragma unroll
  for (int tt = 0; tt < 2; tt++) {
    const int tau = 2 * hf + tt;
    {
      const int pp = 16 * tau + (lane & 15);
      const float ar = a_re[pp], ai = a_im[pp];
      const float mag = expf(dt * ar);
      float sn0, cs0; sincos_f(dt * ai, sn0, cs0);
      const float abr = mag * cs0, abi = mag * sn0;
      const float den = ar * ar + ai * ai;
      const float cor = ((abr - 1.f) * ar + abi * ai) / den;
      const float coi = (abi * ar - (abr - 1.f) * ai) / den;
#pragma unroll
      for (int j = 0; j < 8; j++) {
        float vr = 0.f, vi = 0.f;
        if (kq < 2) {
          const float br = b_re[pp * 16 + 8 * kq + j], bi = b_im[pp * 16 + 8 * kq + j];
          vr = cor * br - coi * bi;
          vi = cor * bi + coi * br;
        }
        Are[tt][j] = (short)f2bf(vr);
        Aim[tt][j] = (short)f2bf(vi);
      }
    }
#pragma unroll
    for (int r = 0; r < 4; r++) {
      const int pp = 16 * tau + 4 * kq + r;
      const float mag = expf(dt * a_re[pp]);
      float sn1, cs1; sincos_f(dt * a_im[pp], sn1, cs1);
      lre[tt][r] = mag * cs1;
      lim[tt][r] = mag * sn1;
    }
  }
#pragma unroll
  for (int ks = 0; ks < 2; ks++) {
#pragma unroll
    for (int j = 0; j < 8; j++) {
      const int pp = 16 * (2 * hf + (j >> 2)) + 4 * kq + (j & 3);
      const float v = (ks == 0) ? c_re[b * 64 + pp] : -c_im[b * 64 + pp];
      Cf[ks][j] = (short)f2bf(v);
    }
  }
  f32x4 sre[2], sim[2];
#pragma unroll
  for (int tt = 0; tt < 2; tt++) { sre[tt] = f32x4{0.f, 0.f, 0.f, 0.f}; sim[tt] = f32x4{0.f, 0.f, 0.f, 0.f}; }
  const bfu* Zu = wsb(p, OFF_BIG + B_ZU) + g * 16 + 8 * (kq & 1);
  bfu* Y = wsb(p, OFF_BIG + (dir ? B_YB : B_YF)) + g * 16 + 4 * kq;
  __syncthreads();
  int gblk = 0;
#pragma unroll 1
  for (int seg = 0; seg < 2; seg++) {
    const int Lseg = seg ? 2048 : 256;
    const int tokbase = seg ? b * 2048 : NLAT + b * 256;
    const int nblk = Lseg >> 3;
    uint4 ucur[8], unext[8];
    if (active) {
#pragma unroll
      for (int s = 0; s < 8; s++) {
        const int t = dir ? Lseg - 1 - s : s;
        ucur[s] = *(const uint4*)(Zu + (size_t)(tokbase + t) * 768);
      }
    }
#pragma unroll 1
    for (int blk = 0; blk < nblk; blk++, gblk++) {
      float* exb = ex + (gblk & 1) * (32 * 64) + lane;
      f32x4 yp[8];
      if (active) {
        if (blk + 1 < nblk) {
#pragma unroll
          for (int s = 0; s < 8; s++) {
            const int st = (blk + 1) * 8 + s;
            const int t = dir ? Lseg - 1 - st : st;
            unext[s] = *(const uint4*)(Zu + (size_t)(tokbase + t) * 768);
          }
        }
#pragma unroll
        for (int s = 0; s < 8; s++) {
          const bf16x8 ub = u4_to_bf8(ucur[s]);
#pragma unroll
          for (int tt = 0; tt < 2; tt++) {
            f32x4 cr, ci;
#pragma unroll
            for (int r = 0; r < 4; r++) {
              cr[r] = lre[tt][r] * sre[tt][r] - lim[tt][r] * sim[tt][r];
              ci[r] = lre[tt][r] * sim[tt][r] + lim[tt][r] * sre[tt][r];
            }
            sre[tt] = mfma16(Are[tt], ub, cr);
            sim[tt] = mfma16(Aim[tt], ub, ci);
          }
          uint4 pr, pi;
          pr.x = pack2(sre[0][0], sre[0][1]); pr.y = pack2(sre[0][2], sre[0][3]);
          pr.z = pack2(sre[1][0], sre[1][1]); pr.w = pack2(sre[1][2], sre[1][3]);
          pi.x = pack2(sim[0][0], sim[0][1]); pi.y = pack2(sim[0][2], sim[0][3]);
          pi.z = pack2(sim[1][0], sim[1][1]); pi.w = pack2(sim[1][2], sim[1][3]);
          f32x4 y = f32x4{0.f, 0.f, 0.f, 0.f};
          y = mfma16(Cf[0], u4_to_bf8(pr), y);
          y = mfma16(Cf[1], u4_to_bf8(pi), y);
          yp[s] = y;
        }
        if (hf == 1) {
#pragma unroll
          for (int s = 0; s < 8; s++)
#pragma unroll
            for (int r = 0; r < 4; r++) exb[(s * 4 + r) * 64] = yp[s][r];
        }
      }
      __syncthreads();
      if (active && hf == 0) {
#pragma unroll
        for (int s = 0; s < 8; s++) {
          const int st = blk * 8 + s;
          const int t = dir ? Lseg - 1 - st : st;
          float q[4];
#pragma unroll
          for (int r = 0; r < 4; r++) q[r] = yp[s][r] + exb[(s * 4 + r) * 64];
          uint2 o;
          o.x = pack2(q[0], q[1]); o.y = pack2(q[2], q[3]);
          *(uint2*)(Y + (size_t)(tokbase + t) * 768) = o;
        }
      }
      if (active) {
#pragma unroll
        for (int s = 0; s < 8; s++) ucur[s] = unext[s];
      }
    }
  }
}

DI void mlstm_job(const PX& p, int l, int job, unsigned char* smem) {
  int tid_ = TIDX(p); OPAQUE(tid_); const int tid = tid_, lane = tid & 63, w = tid >> 6, lr = lane & 31, lh = lane >> 5;
  const int b = job >> 3, h = (job >> 1) & 3, dir = job & 1;
  bfu* sq = (bfu*)smem;
  bfu* sk = sq + 64 * 200;
  bfu* swk = sk + 64 * 200;
  bfu* svT = swk + 192 * 72;
  bfu* sS = svT + 224 * 72;
  float* sf = (float*)(sS + 64 * 72);
  float* rA = sf; float* muA = sf + 128; float* wkA = sf + 256; float* winA = sf + 384; float* emtA = sf + 512;
  float* scA = sf + 640; float* denA = sf + 656; float* cw = sf + 720;
  const bfu* Zml = wsb(p, OFF_BIG + B_ZML);
  const float* Zgt = wsf(p, OFF_BIG + B_ZGT);
  bfu* H = wsb(p, OFF_BIG + (dir ? B_HB : B_HF));
  __syncthreads();
  for (int x = tid; x < 384; x += NTHR) {
    const int ch = (x < 192) ? h * 192 + x : 768 + h * 192 + (x - 192);
#pragma unroll
    for (int j = 0; j < 3; j++) cw[j * 384 + x] = p.in[17][(l * 3 + j) * 1536 + ch];
    cw[1152 + x] = p.in[18][l * 1536 + ch];
  }
  for (int x = tid; x < 32 * 72; x += NTHR) svT[192 * 72 + x] = (x < 72) ? (bfu)0x3F80 : (bfu)0;
  const float gbi = p.in[19][l * 16 + (dir ? 8 : 0) + h];
  const float gbf = p.in[19][l * 16 + (dir ? 12 : 4) + h];
  f32x16 st[6];
#pragma unroll
  for (int i = 0; i < 6; i++)
#pragma unroll
    for (int r = 0; r < 16; r++) st[i][r] = 0.f;
  float m = 0.f;
  float pgi = 0.f, pgf = 0.f;
  if (w == 0) {
    const int t = dir ? 255 - lane : lane;
    const int tok = NLAT + b * 256 + t;
    pgi = Zgt[(size_t)tok * 16 + (dir ? 8 : 0) + h];
    pgf = Zgt[(size_t)tok * 16 + (dir ? 12 : 4) + h];
  }
#pragma unroll 1
  for (int cc = 0; cc < 36; cc++) {
    const int seg = cc >= 4;
    const int c = seg ? cc - 4 : cc;
    const int Lseg = seg ? 2048 : 256;
    const int RL = seg ? 64 : 256;
    const int tokbase = seg ? b * 2048 : NLAT + b * 256;
    {
      const int par = cc & 1;
      if (w == 0) {
        const float gi = pgi + gbi;
        const float gf = pgf + gbf;
        const float lf = fminf(gf, 0.f) - log1pf(expf(-fabsf(gf)));
        float bc = lf;
#pragma unroll
        for (int o = 1; o < 64; o <<= 1) { const float v = __shfl_up(bc, o); if (lane >= o) bc += v; }
        const float rr = gi - bc;
        float M = rr;
#pragma unroll
        for (int o = 1; o < 64; o <<= 1) { const float v = __shfl_up(M, o); if (lane >= o) M = fmaxf(M, v); }
        const float mu = fmaxf(m, M);
        const float b63 = __shfl(bc, 63), mu63 = __shfl(mu, 63);
        rA[par * 64 + lane] = rr;
        muA[par * 64 + lane] = mu;
        wkA[par * 64 + lane] = expf(rr - mu63);
        winA[par * 64 + lane] = expf(m - mu);
        emtA[par * 64 + lane] = expf(-(bc + mu));
        if (lane == 0) { scA[par * 4] = expf(m - mu63); scA[par * 4 + 1] = b63 + mu63; }
      }
      __syncthreads();
      if (w == 0 && cc + 1 < 36) {
        const int sg = (cc + 1) >= 4;
        const int pos = (sg ? cc + 1 - 4 : cc + 1) * 64 + lane;
        const int Ls = sg ? 2048 : 256;
        const int t = dir ? Ls - 1 - pos : pos;
        const int tok = (sg ? b * 2048 : NLAT + b * 256) + t;
        pgi = Zgt[(size_t)tok * 16 + (dir ? 8 : 0) + h];
        pgf = Zgt[(size_t)tok * 16 + (dir ? 12 : 4) + h];
      }
      const float dec = scA[par * 4];
      const float mnew = scA[par * 4 + 1];
#pragma unroll
      for (int i = 0; i < 9; i++) {
        const int u = tid + NTHR * i;
        const int which = i / 3;
        const int rem = u - which * 1536;
        const int tau = rem & 63;
        const int d8 = (rem >> 6) * 8;
        const int pos = c * 64 + tau;
        const int t = dir ? Lseg - 1 - pos : pos;
        const int tok = tokbase + t;
        if (which < 2) {
          const bfu* zp = Zml + (size_t)tok * 3072 + which * 768 + h * 192 + d8;
          const int tm = t & (RL - 1);
          const uint4 mid = *(const uint4*)zp;
          const uint4 lft = *(const uint4*)(zp - ((tm != 0) ? 3072 : 0));
          const uint4 rgt = *(const uint4*)(zp + ((tm != RL - 1) ? 3072 : 0));
          const float lvf = (tm != 0) ? 1.f : 0.f, rvf = (tm != RL - 1) ? 1.f : 0.f;
          const unsigned ml_[4] = {lft.x, lft.y, lft.z, lft.w};
          const unsigned mm_[4] = {mid.x, mid.y, mid.z, mid.w};
          const unsigned mr_[4] = {rgt.x, rgt.y, rgt.z, rgt.w};
          const float* cwx = cw + which * 192 + d8;
          float v[8];
#pragma unroll
          for (int e = 0; e < 8; e++) {
            const float a = (e & 1) ? hi16(ml_[e >> 1]) : lo16(ml_[e >> 1]);
            const float bm = (e & 1) ? hi16(mm_[e >> 1]) : lo16(mm_[e >> 1]);
            const float cr = (e & 1) ? hi16(mr_[e >> 1]) : lo16(mr_[e >> 1]);
            float s = cwx[e] * (a * lvf) + cwx[384 + e] * bm + cwx[768 + e] * (cr * rvf) + cwx[1152 + e];
            s = s / (1.f + __expf(-s));
            v[e] = s;
          }
          if (which == 0) {
            uint4 o;
            o.x = pack2(v[0], v[1]); o.y = pack2(v[2], v[3]); o.z = pack2(v[4], v[5]); o.w = pack2(v[6], v[7]);
            *(uint4*)(sq + tau * 200 + d8) = o;
          } else {
            const float wk = wkA[par * 64 + tau];
#pragma unroll
            for (int e = 0; e < 8; e++) v[e] *= 0.07216878364870323f;
            uint4 o;
            o.x = pack2(v[0], v[1]); o.y = pack2(v[2], v[3]); o.z = pack2(v[4], v[5]); o.w = pack2(v[6], v[7]);
            *(uint4*)(sk + tau * 200 + d8) = o;
#pragma unroll
            for (int e = 0; e < 8; e++) swk[(d8 + e) * 72 + tau] = f2bf(wk * v[e]);
          }
        } else {
          const bfu* zp = Zml + (size_t)tok * 3072 + 1536 + h * 192 + d8;
          const uint4 mid = *(const uint4*)zp;
          const unsigned mm_[4] = {mid.x, mid.y, mid.z, mid.w};
#pragma unroll
          for (int e = 0; e < 8; e++) svT[(d8 + e) * 72 + tau] = (bfu)((e & 1) ? (mm_[e >> 1] >> 16) : (mm_[e >> 1] & 0xffffu));
        }
      }
      __syncthreads();
      f32x16 num[2];
#pragma unroll
      for (int r = 0; r < 16; r++) { num[0][r] = 0.f; num[1][r] = 0.f; }
      if (w < 7) {
#pragma unroll
        for (int i = 0; i < 6; i++) {
#pragma unroll
          for (int s2 = 0; s2 < 2; s2++) {
            uint4 pk;
            pk.x = pack2(st[i][8 * s2 + 0], st[i][8 * s2 + 1]);
            pk.y = pack2(st[i][8 * s2 + 2], st[i][8 * s2 + 3]);
            pk.z = pack2(st[i][8 * s2 + 4], st[i][8 * s2 + 5]);
            pk.w = pack2(st[i][8 * s2 + 6], st[i][8 * s2 + 7]);
            const bf16x8 aop = u4_to_bf8(pk);
#pragma unroll
            for (int ti = 0; ti < 2; ti++) {
              const bfu* qp = sq + (ti * 32 + lr) * 200 + 32 * i + 16 * s2 + 4 * lh;
              const uint2 lo = *(const uint2*)qp;
              const uint2 hi = *(const uint2*)(qp + 8);
              const uint4 bq = make_uint4(lo.x, lo.y, hi.x, hi.y);
              num[ti] = mfma32(aop, u4_to_bf8(bq), num[ti]);
            }
          }
        }
#pragma unroll
        for (int ti = 0; ti < 2; ti++) {
          const float wi = winA[par * 64 + ti * 32 + lr];
#pragma unroll
          for (int r = 0; r < 16; r++) num[ti][r] *= wi;
        }
      }
      if (w < 4) {
        const int si = w >> 1, ti = w & 1;
        f32x16 acc;
#pragma unroll
        for (int r = 0; r < 16; r++) acc[r] = 0.f;
#pragma unroll
        for (int kk = 0; kk < 12; kk++) {
          const bf16x8 a = *(const bf16x8*)(sk + (si * 32 + lr) * 200 + kk * 16 + lh * 8);
          const bf16x8 bq = *(const bf16x8*)(sq + (ti * 32 + lr) * 200 + kk * 16 + lh * 8);
          acc = mfma32(a, bq, acc);
        }
        const int t = ti * 32 + lr;
        const float mut = muA[par * 64 + t];
#pragma unroll
        for (int g4 = 0; g4 < 4; g4++) {
          const int s0 = si * 32 + 8 * g4 + 4 * lh;
          float vv[4];
#pragma unroll
          for (int r4 = 0; r4 < 4; r4++) {
            const int s = s0 + r4;
            const float e = __expf(fminf(rA[par * 64 + s] - mut, 0.f));
            vv[r4] = (s <= t) ? acc[4 * g4 + r4] * e : 0.f;
          }
          uint2 o;
          o.x = pack2(vv[0], vv[1]); o.y = pack2(vv[2], vv[3]);
          *(uint2*)(sS + t * 72 + s0) = o;
        }
      }
      __syncthreads();
      if (w < 7) {
#pragma unroll
        for (int ti = 0; ti < 2; ti++) {
#pragma unroll
          for (int kk = 0; kk < 4; kk++) {
            const bf16x8 a = *(const bf16x8*)(svT + (32 * w + lr) * 72 + kk * 16 + lh * 8);
            const bf16x8 bs = *(const bf16x8*)(sS + (ti * 32 + lr) * 72 + kk * 16 + lh * 8);
            num[ti] = mfma32(a, bs, num[ti]);
          }
        }
        if (w == 6 && lh == 0) { denA[lr] = num[0][0]; denA[32 + lr] = num[1][0]; }
#pragma unroll
        for (int i = 0; i < 6; i++) {
#pragma unroll
          for (int r = 0; r < 16; r++) st[i][r] *= dec;
#pragma unroll
          for (int kk = 0; kk < 4; kk++) {
            const bf16x8 a = *(const bf16x8*)(swk + (32 * i + lr) * 72 + kk * 16 + lh * 8);
            const bf16x8 bv = *(const bf16x8*)(svT + (32 * w + lr) * 72 + kk * 16 + lh * 8);
            st[i] = mfma32(a, bv, st[i]);
          }
        }
      }
      __syncthreads();
      if (w < 6) {
#pragma unroll
        for (int ti = 0; ti < 2; ti++) {
          const int tl = ti * 32 + lr;
          const float dn = fmaxf(fabsf(denA[tl]), emtA[par * 64 + tl]);
          const float inv = 1.f / dn;
          const int pos = c * 64 + tl;
          const int t = dir ? Lseg - 1 - pos : pos;
          bfu* dst = H + (size_t)(tokbase + t) * 768 + h * 192 + 32 * w + 4 * lh;
#pragma unroll
          for (int g4 = 0; g4 < 4; g4++) {
            uint2 o;
            o.x = pack2(num[ti][4 * g4] * inv, num[ti][4 * g4 + 1] * inv);
            o.y = pack2(num[ti][4 * g4 + 2] * inv, num[ti][4 * g4 + 3] * inv);
            *(uint2*)(dst + 8 * g4) = o;
          }
        }
      }
      m = mnew;
    }
  }
}

DI void conv_taps(const PX& p, int l, int ch, float (&wt)[4]) {
  wt[0] = p.in[7][(l * 3 + 0) * 2304 + ch];
  wt[1] = p.in[7][(l * 3 + 1) * 2304 + ch];
  wt[2] = p.in[7][(l * 3 + 2) * 2304 + ch];
  wt[3] = p.in[8][l * 2304 + ch];
}
template <int L>
DI void hy_fill_copies(const PX& p, const bfu* __restrict__ Rg, bfu* cp) {
  constexpr int CSTR = 2 * L + 16;
  int tx = TIDX(p); OPAQUE(tx);
  bfu vv[(2 * L + NTHR - 1) / NTHR];
#pragma unroll
  for (int i = 0; i < (2 * L + NTHR - 1) / NTHR; i++) { const int x = tx + i * NTHR; vv[i] = (x < 2 * L) ? Rg[x < 2 * L ? x : 0] : (bfu)0; }
#pragma unroll
  for (int i = 0; i < (2 * L + NTHR - 1) / NTHR; i++) {
    const int x = tx + i * NTHR;
    if (x < 2 * L) {
      const bfu v = (x == 0) ? (bfu)0 : vv[i];
#pragma unroll
      for (int e = 0; e < 8; e++) cp[e * CSTR + x + e] = v;
    }
  }
}
template <int L, int TPW>
DI void hy_mfma(const PX& p, f32x4 (&acc)[TPW], const bfu* cp, const bfu* U) {
  constexpr int CSTR = 2 * L + 16, USTR = L + 8, NS = L / 32;
  int tx = TIDX(p); OPAQUE(tx);
  const int lane = tx & 63, w = tx >> 6;
  const int i = lane & 15, kq = lane >> 4, e = i & 7, ih = i >> 3;
  const bfu* cpe = cp + e * CSTR;
  const bfu* Ub = U + i * USTR + 8 * kq;
#pragma unroll
  for (int m = 0; m < TPW; m++) acc[m] = f32x4{0.f, 0.f, 0.f, 0.f};
  const int qb0 = L / 8 + kq - ih - 2 * (w * TPW);
  if constexpr (TPW == 16) {
    bf16x8 F[16];
#pragma unroll
    for (int m = 0; m < 16; m++) F[m] = *(const bf16x8*)(cpe + 8 * (qb0 - 2 * m));
#pragma unroll 1
    for (int k = 0; k < NS / 8; k++) {
#pragma unroll
      for (int j = 0; j < 8; j++) {
        const int ss = 8 * k + j;
        const int qb = qb0 + 4 * ss;
        F[(0 - 2 * j) & 15] = *(const bf16x8*)(cpe + 8 * qb);
        F[(1 - 2 * j) & 15] = *(const bf16x8*)(cpe + 8 * (qb - 2));
        const bf16x8 bfr = *(const bf16x8*)(Ub + 32 * ss);
#pragma unroll
        for (int m = 0; m < 16; m++) acc[m] = mfma16(F[(m - 2 * j) & 15], bfr, acc[m]);
      }
    }
  } else {
#pragma unroll 1
    for (int ss = 0; ss < NS; ss++) {
      const bf16x8 bfr = *(const bf16x8*)(Ub + 32 * ss);
      const int qb = qb0 + 4 * ss;
#pragma unroll
      for (int m = 0; m < TPW; m++) {
        const bf16x8 afr = *(const bf16x8*)(cpe + 8 * (qb - 2 * m));
        acc[m] = mfma16(afr, bfr, acc[m]);
      }
    }
  }
}
template <int L>
DI void hyena_job(const PX& p, int l, int c, unsigned char* smem) {
  constexpr int CSTR = 2 * L + 16, USTR = L + 8, TPW = L / 128, RL = (L == 2048) ? 64 : 256;
  int tid_ = TIDX(p); OPAQUE(tid_); const int tid = tid_, lane = tid & 63, w = tid >> 6;
  bfu* cp = (bfu*)smem;
  bfu* U = cp + 8 * CSTR;
  const int tokbase = (L == 2048) ? 0 : NLAT;
  const bfu* Rg = (const bfu*)(p.ws + OFF_FILT + ((L == 2048) ? (size_t)l * FILT_L : 2 * FILT_L)) + (size_t)c * (2 * L);
  const bfu* Zhy = wsb(p, OFF_BIG + B_ZHY);
  const bfu* zv = Zhy + (size_t)c * NTOK + tokbase;
  const bfu* zx1 = Zhy + (size_t)(768 + c) * NTOK + tokbase;
  const bfu* zx2 = Zhy + (size_t)(1536 + c) * NTOK + tokbase;
  float wv[4], w1[4], w2[4];
  conv_taps(p, l, c, wv);
  conv_taps(p, l, 768 + c, w1);
  conv_taps(p, l, 1536 + c, w2);
  const float bias0 = p.in[16][(l * 2 + 0) * 768 + c];
  const float bias1 = p.in[16][(l * 2 + 1) * 768 + c];
  __syncthreads();
  hy_fill_copies<L>(p, Rg, cp);
#pragma unroll
  for (int ui = 0; ui < (16 * (L / 8)) / NTHR; ui++) {
    const int u = tid + ui * NTHR;
    const int b = u / (L / 8), s8 = (u % (L / 8)) * 8;
    const bfu* zr = zv + b * L;
    const uint4 mid = *(const uint4*)(zr + s8);
    const bool lv = (s8 % RL != 0), rv = ((s8 + 8) % RL != 0);
    const float lft = bf2f(zr[lv ? s8 - 1 : s8]) * (lv ? 1.f : 0.f);
    const float rgt = bf2f(zr[rv ? s8 + 8 : s8]) * (rv ? 1.f : 0.f);
    float z[10];
    z[0] = lft; z[9] = rgt;
    z[1] = lo16(mid.x); z[2] = hi16(mid.x); z[3] = lo16(mid.y); z[4] = hi16(mid.y);
    z[5] = lo16(mid.z); z[6] = hi16(mid.z); z[7] = lo16(mid.w); z[8] = hi16(mid.w);
    float o[8];
#pragma unroll
    for (int e = 0; e < 8; e++) o[e] = wv[0] * z[e] + wv[1] * z[e + 1] + wv[2] * z[e + 2] + wv[3];
    uint4 pk;
    pk.x = pack2(o[0], o[1]); pk.y = pack2(o[2], o[3]); pk.z = pack2(o[4], o[5]); pk.w = pack2(o[6], o[7]);
    *(uint4*)(U + b * USTR + s8) = pk;
  }
  __syncthreads();
  const int b = lane & 15, kq = lane >> 4;
  uint2 y1pk[TPW];
  {
    f32x4 acc[TPW];
    hy_mfma<L, TPW>(p, acc, cp, U);
    int kq_o = kq;
    OPAQUE(kq_o);
#pragma unroll
    for (int m = 0; m < TPW; m++) {
      const int t0 = 16 * (w * TPW + m) + 4 * kq_o;
      const bfu* zr = zx1 + b * L;
      const uint2 mid = *(const uint2*)(zr + t0);
      const bool lv = (t0 % RL != 0), rv = ((t0 + 4) % RL != 0);
      const float lft = bf2f(zr[lv ? t0 - 1 : t0]) * (lv ? 1.f : 0.f);
      const float rgt = bf2f(zr[rv ? t0 + 4 : t0]) * (rv ? 1.f : 0.f);
      float z[6];
      z[0] = lft; z[5] = rgt; z[1] = lo16(mid.x); z[2] = hi16(mid.x); z[3] = lo16(mid.y); z[4] = hi16(mid.y);
      const uint2 vu = *(const uint2*)(U + b * USTR + t0);
      const float vv[4] = {lo16(vu.x), hi16(vu.x), lo16(vu.y), hi16(vu.y)};
      float y[4];
#pragma unroll
      for (int r = 0; r < 4; r++) {
        const float x1 = w1[0] * z[r] + w1[1] * z[r + 1] + w1[2] * z[r + 2] + w1[3];
        y[r] = x1 * (acc[m][r] + bias0 * vv[r]);
      }
      y1pk[m].x = pack2(y[0], y[1]);
      y1pk[m].y = pack2(y[2], y[3]);
    }
  }
  __syncthreads();
#pragma unroll
  for (int m = 0; m < TPW; m++) *(uint2*)(U + b * USTR + 16 * (w * TPW + m) + 4 * kq) = y1pk[m];
  hy_fill_copies<L>(p, Rg + (size_t)768 * (2 * L), cp);
  __syncthreads();
  {
    f32x4 acc[TPW];
    hy_mfma<L, TPW>(p, acc, cp, U);
    bfu* yrow = (bfu*)zv;
    int kq_o = kq;
    OPAQUE(kq_o);
#pragma unroll
    for (int m = 0; m < TPW; m++) {
      const int t0 = 16 * (w * TPW + m) + 4 * kq_o;
      const bfu* zr = zx2 + b * L;
      const uint2 mid = *(const uint2*)(zr + t0);
      const bool lv = (t0 % RL != 0), rv = ((t0 + 4) % RL != 0);
      const float lft = bf2f(zr[lv ? t0 - 1 : t0]) * (lv ? 1.f : 0.f);
      const float rgt = bf2f(zr[rv ? t0 + 4 : t0]) * (rv ? 1.f : 0.f);
      float z[6];
      z[0] = lft; z[5] = rgt; z[1] = lo16(mid.x); z[2] = hi16(mid.x); z[3] = lo16(mid.y); z[4] = hi16(mid.y);
      const uint2 vu = *(const uint2*)(U + b * USTR + t0);
      const float vv[4] = {lo16(vu.x), hi16(vu.x), lo16(vu.y), hi16(vu.y)};
      float y2[4];
#pragma unroll
      for (int r = 0; r < 4; r++) {
        const float x2 = w2[0] * z[r] + w2[1] * z[r + 1] + w2[2] * z[r + 2] + w2[3];
        y2[r] = x2 * (acc[m][r] + bias1 * vv[r]);
      }
      uint2 o2; o2.x = pack2(y2[0], y2[1]); o2.y = pack2(y2[2], y2[3]);
      *(uint2*)(yrow + b * L + t0) = o2;
    }
  }
}

DI void branch_phase(const PX& p, int l, int slot, unsigned char* smem, int mode = 3) {
  __shared__ int sjob;
  if (mode & 1)
  for (int jb = blockIdx.x; jb < 176; jb += gridDim.x) {
    if (jb < 48) { if (EN & 16) s5_job(p, l, jb, smem); }
    else { if (EN & 32) mlstm_job(p, l, jb - 48, smem); }
  }
  unsigned* cnt = (unsigned*)(p.ws + OFF_CNT) + slot;
  const int nj = (mode & 2) ? ((l == 0) ? 1536 : 768) : 0;
  while (true) {
    __syncthreads();
    if (TIDX(p) == 0) sjob = (int)atomicAdd(cnt, 1u);
    __syncthreads();
    const int j = sjob;
    if (j >= nj) break;
    if (j < 768) { if (EN & 64) hyena_job<2048>(p, l, j, smem); }
    else { if (EN & 128) hyena_job<256>(p, l, j - 768, smem); }
  }
}

DI void gbar(const PX& p, unsigned target) {
  asm volatile("s_waitcnt vmcnt(0)" ::: "memory");
  __syncthreads();
  if (TIDX(p) == 0) {
    unsigned* cnt = (unsigned*)(p.ws + OFF_CNT) + 32;
    __builtin_amdgcn_fence(__ATOMIC_RELEASE, "agent");
    asm volatile("s_waitcnt vmcnt(0)" ::: "memory");
    __hip_atomic_fetch_add(cnt, 1u, __ATOMIC_RELAXED, __HIP_MEMORY_SCOPE_AGENT);
    unsigned spins = 0;
    while (__hip_atomic_load(cnt, __ATOMIC_RELAXED, __HIP_MEMORY_SCOPE_AGENT) < target) {
      __builtin_amdgcn_s_sleep(2);
      if (++spins > (1u << 26)) break;
    }
    __builtin_amdgcn_fence(__ATOMIC_ACQUIRE, "agent");
    asm volatile("s_waitcnt vmcnt(0)" ::: "memory");
  }
  __syncthreads();
}
#define NPHASE 23
#define SMEM_BYTES 135168
__global__ void __launch_bounds__(NTHR) mega(P p0, int ph_lo, int ph_hi) {
  PX p;
  *(P*)&p = p0;
  p.wv = __builtin_amdgcn_readfirstlane((int)(threadIdx.x >> 6));
  __shared__ __attribute__((aligned(16))) unsigned char smem[SMEM_BYTES];
  cg::grid_group grid = cg::this_grid();
  for (int ph = ph_lo; ph < ph_hi; ph++) {
    if (ph == 0) { if (EN & 1) phase0(p, smem); if (REP0) { grid.sync(); phase0(p, smem); } }
    else if (ph == 1) { phase1(p); if (REP0) { grid.sync(); phase1(p); } }
    else if (ph == 2) { phase2(p); if (REP0) { grid.sync(); phase2(p); } }
    else {
      const int l = (ph - 3) / 10, i = (ph - 3) % 10;
      const int nrep = (((REP >> i) & 1) && (i != 5 || l == 0)) ? 2 : 1;
      for (int rp = 0; rp < nrep; rp++) {
      if (rp) grid.sync();
      const int M = (l == 0) ? NTOK : NLAT;
      const bfu* W1 = wsb(p, OFF_W1);
      const bfu* W2 = wsb(p, OFF_BIG + B_W2);
      if (i == 0) {
        if (EN & 2) gemm_phase<EPI_INPROJ>(p, l, wsb(p, OFF_H), W1 + W1_WIN, 2048, NTOK, 24, 0, false, smem);
        if (gridDim.x > 128) { if (blockIdx.x >= 128) gate_gemm(p, blockIdx.x - 128, gridDim.x - 128); }
        else gate_gemm(p, blockIdx.x, gridDim.x);
      }
      else if (i == 1) {
        if (EN & 4) branch_phase(p, l, l + 2 * rp, smem);
#if PAIR
        grid.sync();
        gemm_phase<EPI_INPROJ>(p, l, wsb(p, OFF_H), W1 + W1_WIN, 2048, NTOK, 25, 0, false, smem);
        grid.sync();
        branch_phase(p, l, l + 4, smem, PAIR);
#endif
      }
      else if (i == 2) post_scan(p, l, M, smem);
      else if (i == 3) gemm_phase<EPI_GLU>(p, l, wsb(p, OFF_BIG + B_YF), W1 + W1_GLU, 768, M, 3, 0, false, smem);
      else if (i == 4) { if (EN & 8) merge_phase(p, NLAT, smem, M - NLAT); }
      else if (i == 5) gemm_phase<EPI_RES>(p, l, wsb(p, OFF_BIG + B_ZHY), W1 + W1_WOUT, 2048, NLAT, 8, 2, l == 0, smem, M - NLAT);
      else if (i == 6) {
        ln_pass(p, l, 0, M);
        const int total = FFN_TILES + ((l == 0) ? MIX_TILES : 0);
        for (int rc = 0; rc < 1 + REPC; rc++)
        for (int it = blockIdx.x; it < total; it += gridDim.x) {
          if (it < FFN_TILES) convert_ffn(p, l, it, (float*)smem);
          else convert_mixer(p, l + 1, it - FFN_TILES, (float*)smem);
        }
      }
      else if (i == 7) gemm_phase<EPI_FF1>(p, l, wsb(p, OFF_H), W2, 2048, M, 32, 0, false, smem);
      else if (i == 8) gemm_phase<EPI_RES>(p, l, wsb(p, OFF_BIG), W2 + (size_t)8192 * 2048, 8192, NLAT, 8, 5, false, smem, M - NLAT);
      else ln_pass(p, l, 1, M);
      }
    }
    if (ph + 1 < ph_hi) {
      if (ph == ph_lo) grid.sync();
      else gbar(p, (unsigned)(ph - ph_lo) * gridDim.x);
    }
  }
}

#ifndef SINGLE_LAUNCH
#define SINGLE_LAUNCH 1
#endif

extern "C" void kernel_launch(void* const* d_in, const int* in_sizes, int n_in, void* d_out, int out_size, void* d_ws,
                              size_t ws_size, hipStream_t stream) {
  P p;
  memset(&p, 0, sizeof(p));
  for (int i = 0; i < 41; i++) p.in[i] = (const float*)d_in[i];
  p.out = (float*)d_out;
  p.ws = (unsigned char*)d_ws;
  if (ws_size < WS_NEED) { fprintf(stderr, "workspace too small: %zu < %zu\n", ws_size, WS_NEED); return; }
#if SINGLE_LAUNCH
  static int grid_blocks = 0;
  if (!grid_blocks) {
    int dev = 0, cus = 0, per_cu = 0;
    hipGetDevice(&dev);
    hipDeviceGetAttribute(&cus, hipDeviceAttributeMultiprocessorCount, dev);
    hipOccupancyMaxActiveBlocksPerMultiprocessor(&per_cu, mega, NTHR, 0);
    if (per_cu < 1) per_cu = 1;
    if (per_cu > 1) per_cu = 1;
    grid_blocks = cus * per_cu;
  }
  int lo = 0, hi = NPHASE;
  void* args[] = {&p, &lo, &hi};
  hipError_t e = hipLaunchCooperativeKernel((void*)mega, dim3(grid_blocks), dim3(NTHR), args, 0, stream);
  if (e != hipSuccess) fprintf(stderr, "cooperative launch failed: %s (grid %d)\n", hipGetErrorString(e), grid_blocks);
#else
  for (int ph = 0; ph < NPHASE; ph++) mega<<<dim3(256), dim3(NTHR), 0, stream>>>(p, ph, ph + 1);
#endif
}
```

```cpp
#include <hip/hip_runtime.h>
#include <hip/hip_cooperative_groups.h>
#include <cstdio>
#include <cstring>
namespace cg = cooperative_groups;

#define DI __device__ __forceinline__
#ifndef REP
#define REP 0
#endif
#ifndef REP0
#define REP0 0
#endif
#ifndef REPC
#define REPC 0
#endif
#ifndef PAIR
#define PAIR 0
#endif
#ifndef EN
#define EN 0xFFFF
#endif
#define OPAQUE(x) asm volatile("" : "+v"(x))
typedef unsigned short bfu;
using bf16x8 = __attribute__((ext_vector_type(8))) short;
using f32x4  = __attribute__((ext_vector_type(4))) float;
using f32x16 = __attribute__((ext_vector_type(16))) float;

#define DM 2048
#define NTOK 36864
#define NLAT 32768
#define NIN 12304
#define NTHR 512
#define ALPHA 1.41421356237309515f

constexpr size_t W1_WIN = 0;
constexpr size_t W1_WOUT = (size_t)NIN * 2048;
constexpr size_t W1_WHY = W1_WOUT + (size_t)2048 * 2048;
constexpr size_t W1_WML = W1_WHY + (size_t)2048 * 768;
constexpr size_t W1_WS5 = W1_WML + (size_t)2048 * 768;
constexpr size_t W1_GLU = W1_WS5 + (size_t)2048 * 768;
constexpr size_t W1_ELEMS = W1_GLU + (size_t)768 * 768;
constexpr size_t OFF_W1 = 0;
constexpr size_t OFF_H = OFF_W1 + W1_ELEMS * 2;
constexpr size_t OFF_CTX = OFF_H + (size_t)NTOK * 2048 * 2;
constexpr size_t OFF_MOD = OFF_CTX + (size_t)4096 * 2048 * 4;
constexpr size_t OFF_FILT = OFF_MOD + (size_t)2 * 17 * 12288 * 4;
constexpr size_t FILT_L = (size_t)2 * 768 * 4096 * 2;
constexpr size_t OFF_CNT = OFF_FILT + 2 * FILT_L + (size_t)2 * 768 * 512 * 2;
constexpr size_t OFF_STATS = OFF_CNT + 256;
constexpr size_t OFF_BIG = OFF_STATS + (size_t)2 * NTOK * 2 * 4;
constexpr size_t SEG = (size_t)NTOK * 768 * 2;
constexpr size_t B_ZHY = 0;
constexpr size_t B_ZML = B_ZHY + (size_t)2304 * NTOK * 2;
constexpr size_t B_ZGT = B_ZML + (size_t)NTOK * 3072 * 2;
constexpr size_t B_ZU = B_ZGT + (size_t)NTOK * 16 * 4;
constexpr size_t B_YHY = B_ZU + SEG;
constexpr size_t B_HF = B_YHY + SEG;
constexpr size_t B_HB = B_HF + SEG;
constexpr size_t B_YF = B_HB + SEG;
constexpr size_t B_YB = B_YF + SEG;
constexpr size_t B_END = B_YB + SEG;
constexpr size_t WS_NEED = (size_t)1073741824;
constexpr size_t BIG_SIZE = WS_NEED - OFF_BIG;
constexpr size_t B_W2 = BIG_SIZE - (size_t)2 * 8192 * 2048 * 2;
static_assert(B_END <= BIG_SIZE, "ws");
static_assert(B_W2 >= B_YF + SEG, "w2 may only overlap Yb");
static_assert((size_t)NTOK * 8192 * 2 <= B_W2, "hidden");

struct P {
  const float* in[41];
  float* out;
  unsigned char* ws;
};
struct PX : P { int wv; };
#define TIDX(p) ((p).wv * 64 + (int)__builtin_amdgcn_mbcnt_hi(~0u, __builtin_amdgcn_mbcnt_lo(~0u, 0u)))

DI float bf2f(bfu v) { return __uint_as_float(((unsigned)v) << 16); }
DI bfu f2bf(float x) { return __builtin_bit_cast(unsigned short, (__bf16)x); }
typedef float f32x2_t __attribute__((ext_vector_type(2)));
typedef __bf16 bf16x2_t __attribute__((ext_vector_type(2)));
DI unsigned pack2(float a, float b) { f32x2_t v = {a, b}; bf16x2_t r = __builtin_convertvector(v, bf16x2_t); return __builtin_bit_cast(unsigned, r); }
DI float lo16(unsigned u) { return __uint_as_float(u << 16); }
DI float hi16(unsigned u) { return __uint_as_float(u & 0xffff0000u); }
DI float sigmoidf_(float x) { return 1.f / (1.f + __expf(-x)); }
DI void sincos_f(float x, float& s, float& c) {
  const float n = rintf(x * 0.6366197723675814f);
  float r = fmaf(n, -1.5703125f, x);
  r = fmaf(n, -4.837512969970703125e-4f, r);
  r = fmaf(n, -7.54978995489188216e-8f, r);
  const int q = (int)n;
  const float r2 = r * r;
  const float sp = r + r * r2 * (-1.6666654611e-1f + r2 * (8.3321608736e-3f + r2 * (-1.9515295891e-4f)));
  const float cp = 1.f - 0.5f * r2 + r2 * r2 * (4.166664568298827e-2f + r2 * (-1.388731625493765e-3f + r2 * 2.443315711809948e-5f));
  const float ss = (q & 1) ? cp : sp;
  const float cc = (q & 1) ? sp : cp;
  s = (q & 2) ? -ss : ss;
  c = ((q + 1) & 2) ? -cc : cc;
}
DI float sin_f(float x) { float s_, c_; sincos_f(x, s_, c_); return s_; }
DI float wave_sum(float v) {
#pragma unroll
  for (int o = 32; o >= 1; o >>= 1) v += __shfl_xor(v, o);
  return v;
}
DI f32x16 mfma32(bf16x8 a, bf16x8 b, f32x16 c) { return __builtin_amdgcn_mfma_f32_32x32x16_bf16(a, b, c, 0, 0, 0); }
DI f32x4 mfma16(bf16x8 a, bf16x8 b, f32x4 c) { return __builtin_amdgcn_mfma_f32_16x16x32_bf16(a, b, c, 0, 0, 0); }
DI bf16x8 u4_to_bf8(uint4 u) { return __builtin_bit_cast(bf16x8, u); }

DI bfu* wsb(const PX& p, size_t off) { return (bfu*)(p.ws + off); }
DI float* wsf(const PX& p, size_t off) { return (float*)(p.ws + off); }
DI float* stream_row(const PX& p, int r) {
  return r < NLAT ? p.out + (size_t)r * DM : wsf(p, OFF_CTX) + (size_t)(r - NLAT) * DM;
}
DI const float* input_row(const PX& p, int r) {
  return r < NLAT ? p.in[0] + (size_t)r * DM : p.in[2] + (size_t)(r - NLAT) * DM;
}
DI int modrow(int r) { return r < NLAT ? (r >> 11) : 16; }
DI const float* mods(const PX& p, int l, int mb, int chunk) {
  return wsf(p, OFF_MOD) + ((size_t)(l * 17 + mb) * 12288 + chunk * 2048);
}

#define LDS3 __attribute__((address_space(3)))
DI int lds_byte(int r, int c) {
  const int st = (r >> 4) * 2 + (c >> 5), rr = r & 15, cc = c & 31, ob = rr * 64 + cc * 2;
  return st * 1024 + (ob ^ (((ob >> 9) & 1) << 5));
}
DI void stage_rc(int b, int& R, int& C) {
  const int st = b / 1024, sb = b % 1024, swz = sb ^ (((sb >> 9) & 1) << 5);
  R = (st >> 1) * 16 + swz / 64;
  C = (st & 1) * 32 + (swz % 64) / 2;
}
template <int HM>
DI void kloop256(const PX& p, f32x4 (&acc)[2][2][4][2], const bfu* __restrict__ A, const bfu* __restrict__ Bt, const int K,
                 const int brow, const int bcol, bfu* shm, const bool pre = false) {
  constexpr int BK = 64, HALF = 128, HT = HALF * BK;
  int tid_ = TIDX(p); OPAQUE(tid_);
  const int tid = tid_;
  const int wid = tid >> 6, lane = tid & 63, wr = wid >> 2, wc = wid & 3, fr = lane & 15, fq = lane >> 4;
#define SA(b, h) (shm + ((b) * 2 + (h)) * HT)
#define SB(b, h) (shm + (4 + (b) * 2 + (h)) * HT)
  unsigned oa0, oa1, obb0, obb1;
  { int r_, c_;
    stage_rc(tid * 16, r_, c_); oa0 = (unsigned)(r_ * K + c_) * 2u;
    { const int rho = r_ & 31, pr = (r_ & ~31) + 8 * ((rho & 15) >> 2) + 4 * (rho >> 4) + (rho & 3); obb0 = (unsigned)(pr * K + c_) * 2u; }
    stage_rc(tid * 16 + 8192, r_, c_); oa1 = (unsigned)(r_ * K + c_) * 2u;
    { const int rho = r_ & 31, pr = (r_ & ~31) + 8 * ((rho & 15) >> 2) + 4 * (rho >> 4) + (rho & 3); obb1 = (unsigned)(pr * K + c_) * 2u; } }
  const int wvb_ = p.wv * 1024;
#define STAGE_(Pp, BASE, br, kt, O0, O1)                                                                   \
  do {                                                                                                     \
    const char* _g = (const char*)(BASE + (long)(br) * K + (long)(kt) * BK);                               \
    __builtin_amdgcn_global_load_lds((const unsigned*)(_g + O0), (LDS3 unsigned*)((char*)(Pp) + wvb_), 16, 0, 0); \
    __builtin_amdgcn_global_load_lds((const unsigned*)(_g + O1), (LDS3 unsigned*)((char*)(Pp) + wvb_ + 8192), 16, 0, 0); \
  } while (0)
#define STAGEA(Pp, BASE, br, kt) STAGE_(Pp, BASE, br, kt, oa0, oa1)
#define STAGEB(Pp, BASE, br, kt) STAGE_(Pp, BASE, br, kt, obb0, obb1)
  const unsigned sbase_ = (unsigned)(size_t)shm;
  const unsigned fsw_ = (unsigned)((fr * 64 + fq * 16) ^ ((((fr * 64 + fq * 16) >> 9) & 1) << 5));
  const unsigned aA_ = sbase_ + wr * 8192 + fsw_;
  const unsigned aB_ = sbase_ + 65536 + wc * 4096 + fsw_;
#define DSR(dstv, addr, off) asm volatile("ds_read_b128 %0, %1 offset:%2" : "=v"(dstv) : "v"(addr), "n"(off) : "memory")
#define LDA(dst, b, h)                                                  \
  do {                                                                  \
    DSR(dst[0][0], aA_, (2 * (b) + (h)) * 16384 + 0);                   \
    DSR(dst[0][1], aA_, (2 * (b) + (h)) * 16384 + 1024);                \
    DSR(dst[1][0], aA_, (2 * (b) + (h)) * 16384 + 2048);                \
    DSR(dst[1][1], aA_, (2 * (b) + (h)) * 16384 + 3072);                \
    DSR(dst[2][0], aA_, (2 * (b) + (h)) * 16384 + 4096);                \
    DSR(dst[2][1], aA_, (2 * (b) + (h)) * 16384 + 5120);                \
    DSR(dst[3][0], aA_, (2 * (b) + (h)) * 16384 + 6144);                \
    DSR(dst[3][1], aA_, (2 * (b) + (h)) * 16384 + 7168);                \
  } while (0)
#define LDB(dst, b, h)                                                  \
  do {                                                                  \
    DSR(dst[0][0], aB_, (2 * (b) + (h)) * 16384 + 0);                   \
    DSR(dst[0][1], aB_, (2 * (b) + (h)) * 16384 + 1024);                \
    DSR(dst[1][0], aB_, (2 * (b) + (h)) * 16384 + 2048);                \
    DSR(dst[1][1], aB_, (2 * (b) + (h)) * 16384 + 3072);                \
  } while (0)
#define MMA(ai, bj, At_, Bt_)                                                                              \
  do {                                                                                                     \
    __builtin_amdgcn_s_setprio(1);                                                                         \
    for (int m = 0; m < 4; ++m)                                                                            \
      for (int n = 0; n < 2; ++n)                                                                          \
        for (int k = 0; k < 2; ++k)                                                                        \
          acc[ai][bj][m][n] = __builtin_amdgcn_mfma_f32_16x16x32_bf16(Bt_[n][k], At_[m][k], acc[ai][bj][m][n], 0, 0, 0); \
    __builtin_amdgcn_s_setprio(0);                                                                         \
  } while (0)
#define MMA1(bj, At_, Bt_) do { if (!HM) MMA(1, bj, At_, Bt_); } while (0)
#define WAIT_V(n) asm volatile("s_waitcnt vmcnt(" #n ")" ::: "memory")
#define WAIT_L8 asm volatile("s_waitcnt lgkmcnt(8)" ::: "memory")
#define WAIT_A(A_)                                                                                         \
  asm volatile("s_waitcnt lgkmcnt(0)"                                                                      \
               : "+v"(A_[0][0]), "+v"(A_[0][1]), "+v"(A_[1][0]), "+v"(A_[1][1]), "+v"(A_[2][0]), "+v"(A_[2][1]),   \
                 "+v"(A_[3][0]), "+v"(A_[3][1]) :: "memory")
#define WAIT_B(B_)                                                                                         \
  asm volatile("s_waitcnt lgkmcnt(0)" : "+v"(B_[0][0]), "+v"(B_[0][1]), "+v"(B_[1][0]), "+v"(B_[1][1]) :: "memory")
#define WAIT_AB(A_, B_)                                                                                    \
  asm volatile("s_waitcnt lgkmcnt(0)"                                                                      \
               : "+v"(A_[0][0]), "+v"(A_[0][1]), "+v"(A_[1][0]), "+v"(A_[1][1]), "+v"(A_[2][0]), "+v"(A_[2][1]),   \
                 "+v"(A_[3][0]), "+v"(A_[3][1]), "+v"(B_[0][0]), "+v"(B_[0][1]), "+v"(B_[1][0]), "+v"(B_[1][1])     \
               :: "memory")
#define BAR __builtin_amdgcn_s_barrier()
#define SCHED __builtin_amdgcn_sched_barrier(0)
#pragma unroll
  for (int ai = 0; ai < 2; ai++)
#pragma unroll
    for (int bj = 0; bj < 2; bj++)
#pragma unroll
      for (int m = 0; m < 4; m++)
#pragma unroll
        for (int n = 0; n < 2; n++) acc[ai][bj][m][n] = f32x4{0.f, 0.f, 0.f, 0.f};
  bf16x8 At[4][2], B0[2][2], B1[2][2];
  const int nt = K / BK;
  if (!pre) {
    STAGEB(SB(0, 0), Bt, bcol, 0); STAGEA(SA(0, 0), A, brow, 0);
    STAGEB(SB(0, 1), Bt, bcol + HALF, 0); STAGEA(SA(0, 1), A, brow + HALF, 0);
  }
  if (wr == 1) BAR;
  WAIT_V(4); BAR;
  STAGEB(SB(1, 0), Bt, bcol, 1); STAGEA(SA(1, 0), A, brow, 1); STAGEB(SB(1, 1), Bt, bcol + HALF, 1);
  WAIT_V(6); BAR;
#pragma unroll 1
  for (int t = 0; t < nt - 2; t += 2) {
    LDB(B0, 0, 0); SCHED; LDA(At, 0, 0); STAGEA(SA(1, 1), A, brow + HALF, t + 1);
    WAIT_L8; BAR; WAIT_AB(At, B0); MMA(0, 0, At, B0); BAR; SCHED;
    LDB(B1, 0, 1); STAGEB(SB(0, 0), Bt, bcol, t + 2);
    BAR; WAIT_B(B1); MMA(0, 1, At, B1); BAR;
    LDA(At, 0, 1); STAGEA(SA(0, 0), A, brow, t + 2);
    BAR; WAIT_A(At); MMA1(0, At, B0); BAR; SCHED;
    STAGEB(SB(0, 1), Bt, bcol + HALF, t + 2);
    WAIT_V(6); BAR; MMA1(1, At, B1); BAR;
    LDB(B0, 1, 0); SCHED; LDA(At, 1, 0); STAGEA(SA(0, 1), A, brow + HALF, t + 2);
    WAIT_L8; BAR; WAIT_AB(At, B0); MMA(0, 0, At, B0); BAR; SCHED;
    LDB(B1, 1, 1); STAGEB(SB(1, 0), Bt, bcol, t + 3);
    BAR; WAIT_B(B1); MMA(0, 1, At, B1); BAR;
    LDA(At, 1, 1); STAGEA(SA(1, 0), A, brow, t + 3);
    BAR; WAIT_A(At); MMA1(0, At, B0); BAR; SCHED;
    STAGEB(SB(1, 1), Bt, bcol + HALF, t + 3);
    WAIT_V(6); BAR; MMA1(1, At, B1); BAR;
  }
  { LDB(B0, 0, 0); LDA(At, 0, 0); STAGEA(SA(1, 1), A, brow + HALF, nt - 1);
    BAR; WAIT_AB(At, B0); MMA(0, 0, At, B0); BAR;
    LDB(B1, 0, 1); BAR; WAIT_B(B1); MMA(0, 1, At, B1); BAR;
    LDA(At, 0, 1); WAIT_V(4); BAR; WAIT_A(At); MMA1(0, At, B0); MMA1(1, At, B1); BAR; }
  { LDB(B0, 1, 0); LDA(At, 1, 0); WAIT_V(2); BAR; WAIT_AB(At, B0); MMA(0, 0, At, B0); BAR;
    LDB(B1, 1, 1); WAIT_V(0); BAR; WAIT_B(B1); MMA(0, 1, At, B1); BAR;
    LDA(At, 1, 1); BAR; WAIT_A(At); MMA1(0, At, B0); MMA1(1, At, B1); BAR; }
  if (wr == 0) BAR;
#undef SA
#undef SB
#undef STAGE_
#undef STAGEA
#undef STAGEB
#undef LDA
#undef DSR
#undef LDB
#undef MMA
#undef MMA1
#undef WAIT_V
#undef WAIT_L8
#undef WAIT_A
#undef WAIT_B
#undef WAIT_AB
#undef BAR
#undef SCHED
}
DI void kstage4(const PX& p, const bfu* __restrict__ A, const bfu* __restrict__ Bt, const int K, const int brow, const int bcol, bfu* shm) {
  constexpr int HALF = 128, HT = HALF * 64;
  int tid_ = TIDX(p); OPAQUE(tid_);
  const int tid = tid_;
  const int wvb_ = p.wv * 1024;
  unsigned oa0, oa1, obb0, obb1;
  { int r_, c_;
    stage_rc(tid * 16, r_, c_); oa0 = (unsigned)(r_ * K + c_) * 2u;
    { const int rho = r_ & 31, pr = (r_ & ~31) + 8 * ((rho & 15) >> 2) + 4 * (rho >> 4) + (rho & 3); obb0 = (unsigned)(pr * K + c_) * 2u; }
    stage_rc(tid * 16 + 8192, r_, c_); oa1 = (unsigned)(r_ * K + c_) * 2u;
    { const int rho = r_ & 31, pr = (r_ & ~31) + 8 * ((rho & 15) >> 2) + 4 * (rho >> 4) + (rho & 3); obb1 = (unsigned)(pr * K + c_) * 2u; } }
#define KS_(Pp, BASE, br, O0, O1)                                                                          \
  do {                                                                                                     \
    const char* _g = (const char*)(BASE + (long)(br) * K);                                                 \
    __builtin_amdgcn_global_load_lds((const unsigned*)(_g + O0), (LDS3 unsigned*)((char*)(Pp) + wvb_), 16, 0, 0); \
    __builtin_amdgcn_global_load_lds((const unsigned*)(_g + O1), (LDS3 unsigned*)((char*)(Pp) + wvb_ + 8192), 16, 0, 0); \
  } while (0)
  KS_(shm + 4 * HT, Bt, bcol, obb0, obb1);
  KS_(shm + 0 * HT, A, brow, oa0, oa1);
  KS_(shm + 5 * HT, Bt, bcol + HALF, obb0, obb1);
  KS_(shm + 1 * HT, A, brow + HALF, oa0, oa1);
#undef KS_
}
DI void tile_of(int L, int nM, int nN, int& pm, int& pn) {
  const int nwg = nM * nN;
  int wgid = L;
  { const int q = nwg / 8, r = nwg % 8, xcd = wgid % 8, off = wgid / 8;
    wgid = (xcd < r ? xcd * (q + 1) : r * (q + 1) + (xcd - r) * q) + off; }
  const int nig = 8 * nN, gid = wgid / nig, fm = gid * 8, gsz = min(nM - fm, 8);
  pm = fm + ((wgid % nig) % gsz);
  pn = (wgid % nig) / gsz;
}

enum { EPI_INPROJ = 0, EPI_GLU = 1, EPI_RES = 2, EPI_FF1 = 3, EPI_GATE = 4, EPI_MERGE = 5 };

template <int EPI, int HM>
DI void epi256(const PX& p, int l, f32x4 (&acc)[2][2][4][2], int brow, int bcol, int aux, bool src_input) {
  int tid_ = TIDX(p); OPAQUE(tid_);
  const int wid = tid_ >> 6, lane = tid_ & 63, wr = wid >> 2, wc = wid & 3, fr = lane & 15, fq = lane >> 4;
  f32x4 hg[2][2], hlg[2][2], hlb[2][2];
  if (EPI == EPI_RES) {
    const int mbt = modrow(brow);
#pragma unroll
    for (int bj = 0; bj < 2; bj++) {
      const int c0 = bcol + bj * 128 + wc * 32 + fq * 8;
      const float* gp = mods(p, l, mbt, aux) + c0;
      hg[bj][0] = *(const f32x4*)gp; hg[bj][1] = *(const f32x4*)(gp + 4);
      const int ll = (aux == 5) ? l : (l > 0 ? l - 1 : 0);
      const float* lg = p.in[aux == 5 ? 35 : 37] + ll * 2048 + c0;
      const float* lb = p.in[aux == 5 ? 36 : 38] + ll * 2048 + c0;
      hlg[bj][0] = *(const f32x4*)lg; hlg[bj][1] = *(const f32x4*)(lg + 4);
      hlb[bj][0] = *(const f32x4*)lb; hlb[bj][1] = *(const f32x4*)(lb + 4);
    }
  }
#pragma unroll
  for (int ai = 0; ai < (HM ? 1 : 2); ai++)
#pragma unroll
    for (int bj = 0; bj < 2; bj++)
#pragma unroll
      for (int m = 0; m < 4; m++) {
          const int row = brow + ai * 128 + wr * 64 + m * 16 + fr;
          const int col0 = bcol + bj * 128 + wc * 32 + fq * 8;
          const f32x4 va = acc[ai][bj][m][0], vb = acc[ai][bj][m][1];
          const float v[8] = {va[0], va[1], va[2], va[3], vb[0], vb[1], vb[2], vb[3]};
          if (EPI == EPI_INPROJ) {
            if (col0 < 2304) {
              const bool odd = (fr & 1) != 0;
              bfu* d = wsb(p, OFF_BIG + B_ZHY) + (size_t)(col0 + (odd ? 4 : 0)) * NTOK + (row & ~1);
#pragma unroll
              for (int j = 0; j < 4; j++) {
                const float snd = odd ? v[j] : v[4 + j];
                const float rcv = __shfl_xor(snd, 1);
                const unsigned pr = odd ? pack2(rcv, v[4 + j]) : pack2(v[j], rcv);
                *(unsigned*)(d + (size_t)j * NTOK) = pr;
              }
            } else if (col0 < 5376) {
              uint4 o; o.x = pack2(v[0], v[1]); o.y = pack2(v[2], v[3]); o.z = pack2(v[4], v[5]); o.w = pack2(v[6], v[7]);
              *(uint4*)(wsb(p, OFF_BIG + B_ZML) + (size_t)row * 3072 + (col0 - 2304)) = o;
            } else {
              uint4 o; o.x = pack2(v[0], v[1]); o.y = pack2(v[2], v[3]); o.z = pack2(v[4], v[5]); o.w = pack2(v[6], v[7]);
              *(uint4*)(wsb(p, OFF_BIG + B_ZU) + (size_t)row * 768 + (col0 - 5376)) = o;
            }
          } else if (EPI == EPI_GLU) {
            const float* gbp = p.in[30] + l * 768 + col0;
            const f32x4 g0 = *(const f32x4*)gbp, g1 = *(const f32x4*)(gbp + 4);
            const float gb[8] = {g0[0], g0[1], g0[2], g0[3], g1[0], g1[1], g1[2], g1[3]};
            const uint4 z = *(const uint4*)(wsb(p, OFF_BIG + B_YF) + (size_t)row * 768 + col0);
            const unsigned zz[4] = {z.x, z.y, z.z, z.w};
            unsigned oo[4];
#pragma unroll
            for (int q = 0; q < 4; q++)
              oo[q] = pack2(lo16(zz[q]) * sigmoidf_(v[2 * q] + gb[2 * q]), hi16(zz[q]) * sigmoidf_(v[2 * q + 1] + gb[2 * q + 1]));
            *(uint4*)(wsb(p, OFF_BIG + B_YB) + (size_t)row * 768 + col0) = make_uint4(oo[0], oo[1], oo[2], oo[3]);
          } else if (EPI == EPI_RES) {
            const float* xp = (src_input ? input_row(p, row) : (const float*)stream_row(p, row)) + col0;
            const f32x4 g0 = hg[bj][0], g1 = hg[bj][1];
            f32x4 x0 = *(const f32x4*)xp, x1 = *(const f32x4*)(xp + 4);
            if (!src_input) {
              const float2 st = *(const float2*)(wsf(p, OFF_STATS) + ((size_t)(aux == 5 ? 0 : 1) * NTOK + row) * 2);
              const f32x4 lg0 = hlg[bj][0], lg1 = hlg[bj][1];
              const f32x4 lb0 = hlb[bj][0], lb1 = hlb[bj][1];
#pragma unroll
              for (int j = 0; j < 4; j++) {
                x0[j] = (x0[j] - st.x) * st.y * lg0[j] + lb0[j];
                x1[j] = (x1[j] - st.x) * st.y * lg1[j] + lb1[j];
              }
            }
            f32x4 o0, o1;
#pragma unroll
            for (int j = 0; j < 4; j++) { o0[j] = ALPHA * x0[j] + g0[j] * va[j]; o1[j] = ALPHA * x1[j] + g1[j] * vb[j]; }
            float* dp = stream_row(p, row) + col0;
            *(f32x4*)dp = o0;
            *(f32x4*)(dp + 4) = o1;
          } else if (EPI == EPI_FF1) {
            float t[8];
#pragma unroll
            for (int j = 0; j < 8; j++) { t[j] = fmaxf(v[j], 0.f); t[j] *= t[j]; }
            uint4 o; o.x = pack2(t[0], t[1]); o.y = pack2(t[2], t[3]); o.z = pack2(t[4], t[5]); o.w = pack2(t[6], t[7]);
            *(uint4*)(wsb(p, OFF_BIG) + (size_t)row * 8192 + col0) = o;
          } else if (EPI == EPI_GATE) {
            uint4 o;
            o.x = pack2(sigmoidf_(v[0]), sigmoidf_(v[1])); o.y = pack2(sigmoidf_(v[2]), sigmoidf_(v[3]));
            o.z = pack2(sigmoidf_(v[4]), sigmoidf_(v[5])); o.w = pack2(sigmoidf_(v[6]), sigmoidf_(v[7]));
            *(uint4*)(wsb(p, OFF_BIG + B_ZML) + (size_t)row * 2048 + col0) = o;
          } else if (EPI == EPI_MERGE) {
            const uint4 g = *(const uint4*)(wsb(p, OFF_BIG + B_ZML) + (size_t)row * 2048 + col0);
            uint4* d = (uint4*)(wsb(p, OFF_BIG + B_ZHY) + (size_t)row * 2048 + col0);
            uint4 old = make_uint4(0u, 0u, 0u, 0u);
            if (aux) old = *d;
            const unsigned gg[4] = {g.x, g.y, g.z, g.w}, od[4] = {old.x, old.y, old.z, old.w};
            unsigned oo[4];
#pragma unroll
            for (int q = 0; q < 4; q++)
              oo[q] = pack2(lo16(od[q]) + lo16(gg[q]) * v[2 * q], hi16(od[q]) + hi16(gg[q]) * v[2 * q + 1]);
            *d = make_uint4(oo[0], oo[1], oo[2], oo[3]);
          }
        }
}

template <int EPI>
DI void gemm_phase(const PX& p, int l, const bfu* A, const bfu* Bt, int K, int M, int nN, int aux, bool src_input,
                   unsigned char* smem, int Mh = 0) {
  const int nM = M >> 8;
  const int nF = nM * nN, nHm = Mh >> 7;
  const int total = nF + nHm * nN;
  constexpr bool EARLY = (EPI == EPI_FF1 || EPI == EPI_INPROJ);
  int L = blockIdx.x;
  if (L >= total) return;
  int brow, bcol;
  bool half;
  if (L < nF) { int pm, pn; tile_of(L, nM, nN, pm, pn); brow = pm * 256; bcol = pn * 256; half = false; }
  else { const int Lh = L - nF; brow = M + (Lh & 31) * 128; bcol = (Lh >> 5) * 256; half = true; }
  if (EARLY) kstage4(p, A, Bt, K, brow, bcol, (bfu*)smem);
  while (true) {
    const int Ln = L + gridDim.x;
    const bool has = Ln < total;
    int nbrow = 0, nbcol = 0;
    bool nhalf = false;
    if (has) {
      if (Ln < nF) { int pm, pn; tile_of(Ln, nM, nN, pm, pn); nbrow = pm * 256; nbcol = pn * 256; }
      else { const int Lh = Ln - nF; nbrow = M + (Lh & 31) * 128; nbcol = (Lh >> 5) * 256; nhalf = true; }
    }
    if (!half) {
      f32x4 acc[2][2][4][2];
      kloop256<0>(p, acc, A, Bt, K, brow, bcol, (bfu*)smem, EARLY);
      if (EARLY && has) kstage4(p, A, Bt, K, nbrow, nbcol, (bfu*)smem);
      epi256<EPI, 0>(p, l, acc, brow, bcol, aux, src_input);
    } else {
      f32x4 acc[2][2][4][2];
      kloop256<1>(p, acc, A, Bt, K, brow, bcol, (bfu*)smem, EARLY);
      if (EARLY && has) kstage4(p, A, Bt, K, nbrow, nbcol, (bfu*)smem);
      epi256<EPI, 1>(p, l, acc, brow, bcol, aux, src_input);
    }
    if (!has) break;
    L = Ln; brow = nbrow; bcol = nbcol; half = nhalf;
  }
}

template <int HM>
DI void merge_tile(const PX& p, int brow, int bcol, unsigned char* smem) {
  const bfu* hA = wsb(p, OFF_H);
  const bfu* W1 = wsb(p, OFF_W1);
#pragma unroll 1
  for (int br = 0; br < 3; br++) {
    {
      f32x4 acc[2][2][4][2];
      kloop256<HM>(p, acc, hA, W1 + W1_WIN + (size_t)(6160 + br * 2048) * 2048, 2048, brow, bcol, (bfu*)smem);
      epi256<EPI_GATE, HM>(p, 0, acc, brow, bcol, 0, false);
    }
    {
      f32x4 acc[2][2][4][2];
      const bfu* Y = wsb(p, OFF_BIG + (br == 0 ? B_YHY : (br == 1 ? B_HF : B_YB)));
      const bfu* Wo = W1 + (br == 0 ? W1_WHY : (br == 1 ? W1_WML : W1_WS5));
      kloop256<HM>(p, acc, Y, Wo, 768, brow, bcol, (bfu*)smem);
      epi256<EPI_MERGE, HM>(p, 0, acc, brow, bcol, br, false);
    }
  }
}
DI void merge_phase(const PX& p, int M, unsigned char* smem, int Mh = 0) {
  const int nM = M >> 8;
  const int nF = nM * 8, nHm = Mh >> 7;
  for (int L = blockIdx.x; L < nF + nHm * 8; L += gridDim.x) {
    if (L < nF) {
      int pm, pn;
      tile_of(L, nM, 8, pm, pn);
      merge_tile<0>(p, pm * 256, pn * 256, smem);
    } else {
      const int Lh = L - nF, pmh = Lh & 31, pn = Lh >> 5;
      merge_tile<1>(p, M + pmh * 128, pn * 256, smem);
    }
  }
}

DI void gate_gemm(const PX& p, int wgi, int nwg) {
  int tid_ = TIDX(p); OPAQUE(tid_);
  const int lane = tid_ & 63, w = tid_ >> 6, fr = lane & 15, kq = lane >> 4;
  const bfu* hA = wsb(p, OFF_H);
  const bfu* Wg = wsb(p, OFF_W1) + W1_WIN + (size_t)6144 * 2048 + (size_t)fr * 2048 + 8 * kq;
  float* Zgt = wsf(p, OFF_BIG + B_ZGT);
  for (int rb = wgi * 8 + w; rb < NTOK / 16; rb += nwg * 8) {
    const bfu* ap = hA + (size_t)(rb * 16 + fr) * 2048 + 8 * kq;
    f32x4 acc = f32x4{0.f, 0.f, 0.f, 0.f};
#pragma unroll 8
    for (int ks = 0; ks < 64; ks++) {
      const bf16x8 a = *(const bf16x8*)(ap + 32 * ks);
      const bf16x8 b = *(const bf16x8*)(Wg + 32 * ks);
      acc = mfma16(a, b, acc);
    }
#pragma unroll
    for (int j = 0; j < 4; j++) Zgt[(size_t)(rb * 16 + 4 * kq + j) * 16 + fr] = acc[j];
  }
}

DI void mod_partial(const PX& p, int it, float* sm) {
  int tid_ = TIDX(p); OPAQUE(tid_); const int tid = tid_;
  const int nb = it % 6, ks = (it / 6) % 32, l = it / 192;
  __syncthreads();
  for (int idx = tid; idx < 17 * 64; idx += NTHR) {
    const int j = idx >> 6, kk = idx & 63, k = ks * 64 + kk;
    const float c = j < 16 ? p.in[1][j * 2048 + k] : p.in[3][k];
    sm[idx] = c / (1.f + __expf(-c));
  }
  __syncthreads();
  float4 acc[17];
#pragma unroll
  for (int j = 0; j < 17; j++) acc[j] = make_float4(0.f, 0.f, 0.f, 0.f);
  const int n = nb * 2048 + tid * 4;
  const float* wp = p.in[4] + ((size_t)l * 2048 + ks * 64) * 12288 + n;
#pragma unroll 4
  for (int kk = 0; kk < 64; kk++) {
    const float4 wv = *(const float4*)(wp + (size_t)kk * 12288);
#pragma unroll
    for (int j = 0; j < 17; j++) {
      const float s = sm[j * 64 + kk];
      acc[j].x += s * wv.x; acc[j].y += s * wv.y; acc[j].z += s * wv.z; acc[j].w += s * wv.w;
    }
  }
  float* part = wsf(p, OFF_BIG) + ((size_t)(l * 32 + ks) * 17) * 12288 + n;
#pragma unroll
  for (int j = 0; j < 17; j++) *(float4*)(part + (size_t)j * 12288) = acc[j];
}

DI void cvt_tile(const PX& p, const float* __restrict__ src, bfu* __restrict__ dst, int K, int N, int tile, float* t, bool perm_in = false) {
  const int ntn = (N + 63) >> 6;
  const int kt = tile / ntn, nt = tile - kt * ntn;
  const int k0 = kt * 64, n0 = nt * 64;
  int tidc = TIDX(p); OPAQUE(tidc);
  __syncthreads();
#pragma unroll
  for (int i = 0; i < 2; i++) {
    const int idx = tidc + i * NTHR;
    const int kk = idx >> 4, n4 = (idx & 15) * 4, n = n0 + n4;
    float4 v = make_float4(0.f, 0.f, 0.f, 0.f);
    if (n < N) v = *(const float4*)(src + (size_t)(k0 + kk) * N + n);
    t[kk * 65 + n4] = v.x; t[kk * 65 + n4 + 1] = v.y; t[kk * 65 + n4 + 2] = v.z; t[kk * 65 + n4 + 3] = v.w;
  }
  __syncthreads();
  {
    const int nn = tidc >> 3, k8 = (tidc & 7) * 8, n = n0 + nn;
    if (n < N) {
      uint4 o;
      o.x = pack2(t[(k8 + 0) * 65 + nn], t[(k8 + 1) * 65 + nn]);
      o.y = pack2(t[(k8 + 2) * 65 + nn], t[(k8 + 3) * 65 + nn]);
      o.z = pack2(t[(k8 + 4) * 65 + nn], t[(k8 + 5) * 65 + nn]);
      o.w = pack2(t[(k8 + 6) * 65 + nn], t[(k8 + 7) * 65 + nn]);
      const int dn = (!perm_in || n < 5376 || n >= 6160) ? n : (n < 5392 ? n + 768 : n - 16);
      *(uint4*)(dst + (size_t)dn * K + k0 + k8) = o;
    }
  }
}
#define MIX_TILES 8496
DI void convert_mixer(const PX& p, int l, int tile, float* sm) {
  bfu* W1 = wsb(p, OFF_W1);
  if (tile < 6176) cvt_tile(p, p.in[6] + (size_t)l * 2048 * NIN, W1 + W1_WIN, 2048, NIN, tile, sm, true);
  else if (tile < 7200) cvt_tile(p, p.in[34] + (size_t)l * 2048 * 2048, W1 + W1_WOUT, 2048, 2048, tile - 6176, sm);
  else if (tile < 7584) cvt_tile(p, p.in[31] + (size_t)l * 768 * 2048, W1 + W1_WHY, 768, 2048, tile - 7200, sm);
  else if (tile < 7968) cvt_tile(p, p.in[32] + (size_t)l * 768 * 2048, W1 + W1_WML, 768, 2048, tile - 7584, sm);
  else if (tile < 8352) cvt_tile(p, p.in[33] + (size_t)l * 768 * 2048, W1 + W1_WS5, 768, 2048, tile - 7968, sm);
  else cvt_tile(p, p.in[29] + (size_t)l * 768 * 768, W1 + W1_GLU, 768, 768, tile - 8352, sm);
}
#define FFN_TILES 8192
DI void convert_ffn(const PX& p, int l, int tile, float* sm) {
  bfu* W2 = wsb(p, OFF_BIG + B_W2);
  if (tile < 4096) cvt_tile(p, p.in[39] + (size_t)l * 2048 * 8192, W2, 2048, 8192, tile, sm);
  else cvt_tile(p, p.in[40] + (size_t)l * 8192 * 2048, W2 + (size_t)8192 * 2048, 8192, 2048, tile - 4096, sm);
}

#define N_FILT_ITEMS 544
DI void filter_item(const PX& p, int it, float* sm) {
  int tid_ = TIDX(p); OPAQUE(tid_); const int tid = tid_;
  int l, L, j0;
  bfu* R;
  if (it < 256) { l = 0; L = 2048; j0 = it * 8; R = (bfu*)(p.ws + OFF_FILT); }
  else if (it < 512) { l = 1; L = 2048; j0 = (it - 256) * 8; R = (bfu*)(p.ws + OFF_FILT + FILT_L); }
  else { l = 0; L = 256; j0 = (it - 512) * 8; R = (bfu*)(p.ws + OFF_FILT + 2 * FILT_L); }
  float* feats = sm;
  float* h1 = sm + 320;
  float* h2 = sm + 320 + 512;
  const int lg = tid >> 6, i = tid & 63;
  const int j = j0 + lg;
  const float tj = (float)j / (float)(L - 1);
  __syncthreads();
  if (i < 33) {
    float f;
    if (i == 0) f = tj;
    else {
      const int bi = (i - 1) & 15;
      float bstep = 0.99999333333f, w0 = (L == 2048) ? 0.0030679615757712823f : 0.02454369260617026f;
      OPAQUE(bstep); OPAQUE(w0);
      const float band = 1e-4f + (float)bi * bstep;
      const float a = w0 * (float)j;
      const float ang = a * band;
      float sn, cs; sincos_f(ang, sn, cs);
      f = (i <= 16) ? cs : sn;
    }
    feats[lg * 40 + i] = f;
  }
  __syncthreads();
  const float fr = p.in[14][l * 64 + i];
  {
    float s = p.in[10][l * 64 + i];
    const float* w1 = p.in[9] + (size_t)l * 33 * 64;
#pragma unroll 11
    for (int f = 0; f < 33; f++) s += feats[lg * 40 + f] * w1[f * 64 + i];
    h1[lg * 64 + i] = sin_f(fr * s);
  }
  __syncthreads();
  {
    float s = p.in[12][l * 64 + i];
    const float* w2 = p.in[11] + (size_t)l * 64 * 64;
#pragma unroll 16
    for (int k = 0; k < 64; k++) s += h1[lg * 64 + k] * w2[k * 64 + i];
    h2[lg * 64 + i] = sin_f(fr * s);
  }
  __syncthreads();
  const float* w3 = p.in[13] + (size_t)l * 64 * 3072;
  float sacc[6][8];
#pragma unroll
  for (int q6 = 0; q6 < 6; q6++)
#pragma unroll
    for (int q = 0; q < 8; q++) sacc[q6][q] = 0.f;
#pragma unroll 4
  for (int k = 0; k < 64; k++) {
    float wv[6];
#pragma unroll
    for (int q6 = 0; q6 < 6; q6++) wv[q6] = w3[k * 3072 + tid + NTHR * q6];
#pragma unroll
    for (int q = 0; q < 8; q++) {
      const float hv = h2[q * 64 + k];
#pragma unroll
      for (int q6 = 0; q6 < 6; q6++) sacc[q6][q] += hv * wv[q6];
    }
  }
#pragma unroll
  for (int q6 = 0; q6 < 6; q6++) {
    const int n = tid + NTHR * q6;
    const int o = n / 1536, dir = (n % 1536) / 768, c = n % 768;
    const float dc = fabsf(p.in[15][(l * 2 + o) * 768 + c]);
    bfu* Rc = R + (size_t)(o * 768 + c) * (2 * L);
#pragma unroll
    for (int q = 0; q < 8; q++) {
      const int jj = j0 + q;
      const float tq = (float)jj / (float)(L - 1);
      const float val = sacc[q6][q] * expf(-tq * dc);
      if (dir == 0) Rc[L - jj] = f2bf(val);
      else if (jj > 0) Rc[L + jj] = f2bf(val);
    }
  }
}

DI void phase0(const PX& p, unsigned char* smem) {
  float* sm = (float*)smem;
  if (blockIdx.x == 0 && TIDX(p) < 64) ((unsigned*)(p.ws + OFF_CNT))[TIDX(p)] = 0u;
  const int n_mod = 384;
  const int total = n_mod + MIX_TILES + N_FILT_ITEMS;
  for (int it = blockIdx.x; it < total; it += gridDim.x) {
    if (it < n_mod) { if (EN & 256) mod_partial(p, it, sm); }
    else if (it < n_mod + N_FILT_ITEMS) { if (EN & 512) filter_item(p, it - n_mod, sm); }
    else convert_mixer(p, 0, it - n_mod - N_FILT_ITEMS, sm);
  }
}

DI void phase1(const PX& p) {
  const int total = 2 * 17 * 3072;
  int tx = TIDX(p); OPAQUE(tx);
  for (int u = blockIdx.x * NTHR + tx; u < total; u += gridDim.x * NTHR) {
    const int n = (u % 3072) * 4, j = (u / 3072) % 17, l = u / (3072 * 17);
    float4 s = *(const float4*)(p.in[5] + l * 12288 + n);
    for (int ks = 0; ks < 32; ks++) {
      const float4 v = *(const float4*)(wsf(p, OFF_BIG) + ((size_t)(l * 32 + ks) * 17 + j) * 12288 + n);
      s.x += v.x; s.y += v.y; s.z += v.z; s.w += v.w;
    }
    *(float4*)(wsf(p, OFF_MOD) + (size_t)(l * 17 + j) * 12288 + n) = s;
  }
}

DI void phase2(const PX& p) {
  int tid_ = TIDX(p); OPAQUE(tid_);
  const int lane = tid_ & 63;
  const int wg = blockIdx.x * 8 + (tid_ >> 6), nw = gridDim.x * 8;
  bfu* hA = wsb(p, OFF_H);
  const int rpw = (NTOK + nw - 1) / nw;
  float4 sa[8], sb[8];
#pragma unroll
  for (int i = 0; i < 8; i++) { sa[i] = make_float4(0.f, 0.f, 0.f, 0.f); sb[i] = make_float4(0.f, 0.f, 0.f, 0.f); }
  int mb_cur = -1;
  for (int k = 0; k < rpw; k++) {
    const int r = wg * rpw + k;
    if (r >= NTOK) break;
    const float* x = input_row(p, r);
    float4 v[8];
#pragma unroll
    for (int i = 0; i < 8; i++) v[i] = *(const float4*)(x + lane * 4 + 256 * i);
    const int mb = modrow(r);
    if (mb != mb_cur) {
      mb_cur = mb;
      const float* sh = mods(p, 0, mb, 0);
      const float* sc = mods(p, 0, mb, 1);
#pragma unroll
      for (int i = 0; i < 8; i++) {
        sa[i] = *(const float4*)(sh + lane * 4 + 256 * i);
        sb[i] = *(const float4*)(sc + lane * 4 + 256 * i);
      }
    }
#pragma unroll
    for (int i = 0; i < 8; i++) {
      const int c = lane * 4 + 256 * i;
      uint2 o;
      o.x = pack2(v[i].x * (1.f + sb[i].x) + sa[i].x, v[i].y * (1.f + sb[i].y) + sa[i].y);
      o.y = pack2(v[i].z * (1.f + sb[i].z) + sa[i].z, v[i].w * (1.f + sb[i].w) + sa[i].w);
      *(uint2*)(hA + (size_t)r * 2048 + c) = o;
    }
  }
}

DI void ln_pass(const PX& p, int l, int which, int M) {
  int tid_ = TIDX(p); OPAQUE(tid_);
  const int lane = tid_ & 63;
  const int wg = blockIdx.x * 8 + (tid_ >> 6), nw = gridDim.x * 8;
  const float* g = p.in[which ? 37 : 35] + l * 2048;
  const float* bta = p.in[which ? 38 : 36] + l * 2048;
  const bool emit = (which == 0) || (l + 1 < 2);
  const bool writex = (which == 1) && (l + 1 >= 2);
  float* stats = wsf(p, OFF_STATS) + (size_t)which * NTOK * 2;
  const int ml = which ? l + 1 : l;
  const int ch_sh = which ? 0 : 3, ch_sc = which ? 1 : 4;
  bfu* hA = wsb(p, OFF_H);
  const int rpw = (M + nw - 1) / nw;
  float4 gg[8], bb[8], sa[8], sb[8];
#pragma unroll
  for (int i = 0; i < 8; i++) {
    gg[i] = *(const float4*)(g + lane * 4 + 256 * i);
    bb[i] = *(const float4*)(bta + lane * 4 + 256 * i);
    sa[i] = make_float4(0.f, 0.f, 0.f, 0.f);
    sb[i] = make_float4(0.f, 0.f, 0.f, 0.f);
  }
  int mb_cur = -1;
  for (int k = 0; k < rpw; k++) {
    const int r = wg * rpw + k;
    if (r >= M) break;
    float* x = stream_row(p, r);
    float4 v[8];
    float s = 0.f;
#pragma unroll
    for (int i = 0; i < 8; i++) {
      v[i] = *(const float4*)(x + lane * 4 + 256 * i);
      s += v[i].x + v[i].y + v[i].z + v[i].w;
    }
    const int mb = modrow(r);
    if (emit && mb != mb_cur) {
      mb_cur = mb;
      const float* sh = mods(p, ml, mb, ch_sh);
      const float* sc = mods(p, ml, mb, ch_sc);
#pragma unroll
      for (int i = 0; i < 8; i++) {
        sa[i] = *(const float4*)(sh + lane * 4 + 256 * i);
        sb[i] = *(const float4*)(sc + lane * 4 + 256 * i);
      }
    }
    const float mu = wave_sum(s) * (1.f / 2048.f);
    float q = 0.f;
#pragma unroll
    for (int i = 0; i < 8; i++) {
      v[i].x -= mu; v[i].y -= mu; v[i].z -= mu; v[i].w -= mu;
      q += v[i].x * v[i].x + v[i].y * v[i].y + v[i].z * v[i].z + v[i].w * v[i].w;
    }
    const float rs = rsqrtf(wave_sum(q) * (1.f / 2048.f) + 1e-5f);
    if (!writex && lane == 0) *(float2*)(stats + (size_t)r * 2) = make_float2(mu, rs);
#pragma unroll
    for (int i = 0; i < 8; i++) {
      const int c = lane * 4 + 256 * i;
      float4 y;
      y.x = v[i].x * rs * gg[i].x + bb[i].x; y.y = v[i].y * rs * gg[i].y + bb[i].y;
      y.z = v[i].z * rs * gg[i].z + bb[i].z; y.w = v[i].w * rs * gg[i].w + bb[i].w;
      if (writex) *(float4*)(x + c) = y;
      if (emit) {
        uint2 o;
        o.x = pack2(y.x * (1.f + sb[i].x) + sa[i].x, y.y * (1.f + sb[i].y) + sa[i].y);
        o.y = pack2(y.z * (1.f + sb[i].z) + sa[i].z, y.w * (1.f + sb[i].w) + sa[i].w);
        *(uint2*)(hA + (size_t)r * 2048 + c) = o;
      }
    }
  }
}

DI void post_scan(const PX& p, int l, int M, unsigned char* smem) {
  {
    bfu* tl = (bfu*)smem;
    int tx = TIDX(p); OPAQUE(tx);
    const bfu* Zt = wsb(p, OFF_BIG + B_ZHY);
    bfu* Yh = wsb(p, OFF_BIG + B_YHY);
    const int nt = (M >> 6) * 12;
    for (int it = blockIdx.x; it < nt; it += gridDim.x) {
      const int r0 = (it / 12) * 64, c0 = (it % 12) * 64;
      __syncthreads();
#pragma unroll
      for (int i = 0; i < 2; i++) {
        const int idx = tx + i * NTHR, ci = idx >> 4, t4 = (idx & 15) * 4;
        const uint2 v = *(const uint2*)(Zt + (size_t)(c0 + ci) * NTOK + r0 + t4);
        bfu* d = tl + ci * 66 + t4;
        d[0] = (bfu)(v.x & 0xffffu); d[1] = (bfu)(v.x >> 16); d[2] = (bfu)(v.y & 0xffffu); d[3] = (bfu)(v.y >> 16);
      }
      __syncthreads();
#pragma unroll
      for (int i = 0; i < 2; i++) {
        const int idx = tx + i * NTHR, ti = idx >> 4, c4 = (idx & 15) * 4;
        const bfu* sp = tl + c4 * 66 + ti;
        uint2 o;
        o.x = (unsigned)sp[0] | ((unsigned)sp[66] << 16);
        o.y = (unsigned)sp[132] | ((unsigned)sp[198] << 16);
        *(uint2*)(Yh + (size_t)(r0 + ti) * 768 + c0 + c4) = o;
      }
    }
  }
  int tid_ = TIDX(p); OPAQUE(tid_);
  const int lane = tid_ & 63;
  const int wg = blockIdx.x * 8 + (tid_ >> 6), nw = gridDim.x * 8;
  bfu* Hf = wsb(p, OFF_BIG + B_HF);
  const bfu* Hb = wsb(p, OFF_BIG + B_HB);
  const bfu* Zml = wsb(p, OFF_BIG + B_ZML);
  bfu* Yf = wsb(p, OFF_BIG + B_YF);
  const bfu* Yb = wsb(p, OFF_BIG + B_YB);
  const bfu* Zu = wsb(p, OFF_BIG + B_ZU);
  const float* ng = p.in[20] + l * 768;
  const float* sd = p.in[28] + l * 768;
  float4 ngv[3], sdv[3];
#pragma unroll
  for (int i = 0; i < 3; i++) { ngv[i] = *(const float4*)(ng + lane * 12 + 4 * i); sdv[i] = *(const float4*)(sd + lane * 12 + 4 * i); }
  for (int r = wg; r < M; r += nw) {
    const size_t ro = (size_t)r * 768 + lane * 12;
    {
      float x[12];
      const uint2* hf = (const uint2*)(Hf + ro);
      const uint2* hb = (const uint2*)(Hb + ro);
      float s = 0.f;
#pragma unroll
      for (int i = 0; i < 3; i++) {
        const uint2 a = hf[i], bq = hb[i];
        x[4 * i] = lo16(a.x) + lo16(bq.x); x[4 * i + 1] = hi16(a.x) + hi16(bq.x);
        x[4 * i + 2] = lo16(a.y) + lo16(bq.y); x[4 * i + 3] = hi16(a.y) + hi16(bq.y);
        s += x[4 * i] + x[4 * i + 1] + x[4 * i + 2] + x[4 * i + 3];
      }
#pragma unroll
      for (int o = 8; o >= 1; o >>= 1) s += __shfl_xor(s, o);
      const float mu = s * (1.f / 192.f);
      float q = 0.f;
#pragma unroll
      for (int i = 0; i < 12; i++) { x[i] -= mu; q += x[i] * x[i]; }
#pragma unroll
      for (int o = 8; o >= 1; o >>= 1) q += __shfl_xor(q, o);
      const float rs = rsqrtf(q * (1.f / 192.f) + 1e-5f);
      const uint2* og = (const uint2*)(Zml + (size_t)r * 3072 + 2304 + lane * 12);
      const float4* gg = (const float4*)(ng + lane * 12);
#pragma unroll
      for (int i = 0; i < 3; i++) {
        const uint2 o = og[i];
        const float4 g4 = ngv[i];
        uint2 w_;
        w_.x = pack2(x[4 * i] * rs * g4.x * sigmoidf_(lo16(o.x)), x[4 * i + 1] * rs * g4.y * sigmoidf_(hi16(o.x)));
        w_.y = pack2(x[4 * i + 2] * rs * g4.z * sigmoidf_(lo16(o.y)), x[4 * i + 3] * rs * g4.w * sigmoidf_(hi16(o.y)));
        ((uint2*)(Hf + ro))[i] = w_;
      }
    }
    {
      const uint2* yf = (const uint2*)(Yf + ro);
      const uint2* yb = (const uint2*)(Yb + ro);
      const uint2* zu = (const uint2*)(Zu + ro);
      const float4* dd = (const float4*)(sd + lane * 12);
#pragma unroll
      for (int i = 0; i < 3; i++) {
        const uint2 a = yf[i], bq = yb[i], u = zu[i];
        const float4 d4 = sdv[i];
        float y[4];
        y[0] = lo16(a.x) + lo16(bq.x) + d4.x * lo16(u.x);
        y[1] = hi16(a.x) + hi16(bq.x) + d4.y * hi16(u.x);
        y[2] = lo16(a.y) + lo16(bq.y) + d4.z * lo16(u.y);
        y[3] = hi16(a.y) + hi16(bq.y) + d4.w * hi16(u.y);
#pragma unroll
        for (int j = 0; j < 4; j++) {
          const float uu = 0.7978845608028654f * (y[j] + 0.044715f * y[j] * y[j] * y[j]);
          y[j] = 0.5f * y[j] * (1.f + tanhf(uu));
        }
        uint2 w_;
        w_.x = pack2(y[0], y[1]); w_.y = pack2(y[2], y[3]);
        ((uint2*)(Yf + ro))[i] = w_;
      }
    }
  }
}

DI void s5_job(const PX& p, int l, int job, unsigned char* smem) {
  int tid_ = TIDX(p); OPAQUE(tid_); const int tid = tid_, lane = tid & 63, w = tid >> 6;
  const bool active = w < 4;
  const int cl = (w >> 1) & 1, hf = w & 1;
  const int chain = job * 2 + cl;
  const int g = chain >> 1, dir = chain & 1;
  const int b = lane & 15, kq = lane >> 4;
  const int pg = (l * 2 + dir) * 48 + g;
  const float* a_re = p.in[21] + (size_t)pg * 64;
  const float* a_im = p.in[22] + (size_t)pg * 64;
  const float dt = expf(p.in[23][pg]);
  const float* b_re = p.in[24] + (size_t)pg * 1024;
  const float* b_im = p.in[25] + (size_t)pg * 1024;
  const float* c_re = p.in[26] + (size_t)pg * 1024;
  const float* c_im = p.in[27] + (size_t)pg * 1024;
  float* ex = (float*)smem + cl * (2 * 32 * 64);
  bf16x8 Are[2], Aim[2], Cf[2];
  float lre[2][4], lim[2][4];
#pragma unroll
  for (int tt = 0; tt < 2; tt++) {
    const int tau = 2 * hf + tt;
    {
      const int pp = 16 * tau + (lane & 15);
      const float ar = a_re[pp], ai = a_im[pp];
      const float mag = expf(dt * ar);
      float sn0, cs0; sincos_f(dt * ai, sn0, cs0);
      const float abr = mag * cs0, abi = mag * sn0;
      const float den = ar * ar + ai * ai;
      const float cor = ((abr - 1.f) * ar + abi * ai) / den;
      const float coi = (abi * ar - (abr - 1.f) * ai) / den;
#pragma unroll
      for (int j = 0; j < 8; j++) {
        float vr = 0.f, vi = 0.f;
        if (kq < 2) {
          const float br = b_re[pp * 16 + 8 * kq + j], bi = b_im[pp * 16 + 8 * kq + j];
          vr = cor * br - coi * bi;
          vi = cor * bi + coi * br;
        }
        Are[tt][j] = (short)f2bf(vr);
        Aim[tt][j] = (short)f2bf(vi);
      }
    }
#pragma unroll
    for (int r = 0; r < 4; r++) {
      const int pp = 16 * tau + 4 * kq + r;
      const float mag = expf(dt * a_re[pp]);
      float sn1, cs1; sincos_f(dt * a_im[pp], sn1, cs1);
      lre[tt][r] = mag * cs1;
      lim[tt][r] = mag * sn1;
    }
  }
#pragma unroll
  for (int ks = 0; ks < 2; ks++) {
#pragma unroll
    for (int j = 0; j < 8; j++) {
      const int pp = 16 * (2 * hf + (j >> 2)) + 4 * kq + (j & 3);
      const float v = (ks == 0) ? c_re[b * 64 + pp] : -c_im[b * 64 + pp];
      Cf[ks][j] = (short)f2bf(v);
    }
  }
  f32x4 sre[2], sim[2];
#pragma unroll
  for (int tt = 0; tt < 2; tt++) { sre[tt] = f32x4{0.f, 0.f, 0.f, 0.f}; sim[tt] = f32x4{0.f, 0.f, 0.f, 0.f}; }
  const bfu* Zu = wsb(p, OFF_BIG + B_ZU) + g * 16 + 8 * (kq & 1);
  bfu* Y = wsb(p, OFF_BIG + (dir ? B_YB : B_YF)) + g * 16 + 4 * kq;
  __syncthreads();
  int gblk = 0;
#pragma unroll 1
  for (int seg = 0; seg < 2; seg++) {
    const int Lseg = seg ? 2048 : 256;
    const int tokbase = seg ? b * 2048 : NLAT + b * 256;
    const int nblk = Lseg >> 3;
    uint4 ucur[8], unext[8];
    if (active) {
#pragma unroll
      for (int s = 0; s < 8; s++) {
        const int t = dir ? Lseg - 1 - s : s;
        ucur[s] = *(const uint4*)(Zu + (size_t)(tokbase + t) * 768);
      }
    }
#pragma unroll 1
    for (int blk = 0; blk < nblk; blk++, gblk++) {
      float* exb = ex + (gblk & 1) * (32 * 64) + lane;
      f32x4 yp[8];
      if (active) {
        if (blk + 1 < nblk) {
#pragma unroll
          for (int s = 0; s < 8; s++) {
            const int st = (blk + 1) * 8 + s;
            const int t = dir ? Lseg - 1 - st : st;
            unext[s] = *(const uint4*)(Zu + (size_t)(tokbase + t) * 768);
          }
        }
#pragma unroll
        for (int s = 0; s < 8; s++) {
          const bf16x8 ub = u4_to_bf8(ucur[s]);
#pragma unroll
          for (int tt = 0; tt < 2; tt++) {
            f32x4 cr, ci;
#pragma unroll
            for (int r = 0; r < 4; r++) {
              cr[r] = lre[tt][r] * sre[tt][r] - lim[tt][r] * sim[tt][r];
              ci[r] = lre[tt][r] * sim[tt][r] + lim[tt][r] * sre[tt][r];
            }
            sre[tt] = mfma16(Are[tt], ub, cr);
            sim[tt] = mfma16(Aim[tt], ub, ci);
          }
          uint4 pr, pi;
          pr.x = pack2(sre[0][0], sre[0][1]); pr.y = pack2(sre[0][2], sre[0][3]);
          pr.z = pack2(sre[1][0], sre[1][1]); pr.w = pack2(sre[1][2], sre[1][3]);
          pi.x = pack2(sim[0][0], sim[0][1]); pi.y = pack2(sim[0][2], sim[0][3]);
          pi.z = pack2(sim[1][0], sim[1][1]); pi.w = pack2(sim[1][2], sim[1][3]);
          f32x4 y = f32x4{0.f, 0.f, 0.f, 0.f};
          y = mfma16(Cf[0], u4_to_bf8(pr), y);
          y = mfma16(Cf[1], u4_to_bf8(pi), y);
          yp[s] = y;
        }
        if (hf == 1) {
#pragma unroll
          for (int s = 0; s < 8; s++)
#pragma unroll
            for (int r = 0; r < 4; r++) exb[(s * 4 + r) * 64] = yp[s][r];
        }
      }
      __syncthreads();
      if (active && hf == 0) {
#pragma unroll
        for (int s = 0; s < 8; s++) {
          const int st = blk * 8 + s;
          const int t = dir ? Lseg - 1 - st : st;
          float q[4];
#pragma unroll
          for (int r = 0; r < 4; r++) q[r] = yp[s][r] + exb[(s * 4 + r) * 64];
          uint2 o;
          o.x = pack2(q[0], q[1]); o.y = pack2(q[2], q[3]);
          *(uint2*)(Y + (size_t)(tokbase + t) * 768) = o;
        }
      }
      if (active) {
#pragma unroll
        for (int s = 0; s < 8; s++) ucur[s] = unext[s];
      }
    }
  }
}

DI void mlstm_job(const PX& p, int l, int job, unsigned char* smem) {
  int tid_ = TIDX(p); OPAQUE(tid_); const int tid = tid_, lane = tid & 63, w = tid >> 6, lr = lane & 31, lh = lane >> 5;
  const int b = job >> 3, h = (job >> 1) & 3, dir = job & 1;
  bfu* sq = (bfu*)smem;
  bfu* sk = sq + 64 * 200;
  bfu* swk = sk + 64 * 200;
  bfu* svT = swk + 192 * 72;
  bfu* sS = svT + 224 * 72;
  float* sf = (float*)(sS + 64 * 72);
  float* rA = sf; float* muA = sf + 128; float* wkA = sf + 256; float* winA = sf + 384; float* emtA = sf + 512;
  float* scA = sf + 640; float* denA = sf + 656; float* cw = sf + 720;
  const bfu* Zml = wsb(p, OFF_BIG + B_ZML);
  const float* Zgt = wsf(p, OFF_BIG + B_ZGT);
  bfu* H = wsb(p, OFF_BIG + (dir ? B_HB : B_HF));
  __syncthreads();
  for (int x = tid; x < 384; x += NTHR) {
    const int ch = (x < 192) ? h * 192 + x : 768 + h * 192 + (x - 192);
#pragma unroll
    for (int j = 0; j < 3; j++) cw[j * 384 + x] = p.in[17][(l * 3 + j) * 1536 + ch];
    cw[1152 + x] = p.in[18][l * 1536 + ch];
  }
  for (int x = tid; x < 32 * 72; x += NTHR) svT[192 * 72 + x] = (x < 72) ? (bfu)0x3F80 : (bfu)0;
  const float gbi = p.in[19][l * 16 + (dir ? 8 : 0) + h];
  const float gbf = p.in[19][l * 16 + (dir ? 12 : 4) + h];
  f32x16 st[6];
#pragma unroll
  for (int i = 0; i < 6; i++)
#pragma unroll
    for (int r = 0; r < 16; r++) st[i][r] = 0.f;
  float m = 0.f;
  float pgi = 0.f, pgf = 0.f;
  if (w == 0) {
    const int t = dir ? 255 - lane : lane;
    const int tok = NLAT + b * 256 + t;
    pgi = Zgt[(size_t)tok * 16 + (dir ? 8 : 0) + h];
    pgf = Zgt[(size_t)tok * 16 + (dir ? 12 : 4) + h];
  }
#pragma unroll 1
  for (int cc = 0; cc < 36; cc++) {
    const int seg = cc >= 4;
    const int c = seg ? cc - 4 : cc;
    const int Lseg = seg ? 2048 : 256;
    const int RL = seg ? 64 : 256;
    const int tokbase = seg ? b * 2048 : NLAT + b * 256;
    {
      const int par = cc & 1;
      if (w == 0) {
        const float gi = pgi + gbi;
        const float gf = pgf + gbf;
        const float lf = fminf(gf, 0.f) - log1pf(expf(-fabsf(gf)));
        float bc = lf;
#pragma unroll
        for (int o = 1; o < 64; o <<= 1) { const float v = __shfl_up(bc, o); if (lane >= o) bc += v; }
        const float rr = gi - bc;
        float M = rr;
#pragma unroll
        for (int o = 1; o < 64; o <<= 1) { const float v = __shfl_up(M, o); if (lane >= o) M = fmaxf(M, v); }
        const float mu = fmaxf(m, M);
        const float b63 = __shfl(bc, 63), mu63 = __shfl(mu, 63);
        rA[par * 64 + lane] = rr;
        muA[par * 64 + lane] = mu;
        wkA[par * 64 + lane] = expf(rr - mu63);
        winA[par * 64 + lane] = expf(m - mu);
        emtA[par * 64 + lane] = expf(-(bc + mu));
        if (lane == 0) { scA[par * 4] = expf(m - mu63); scA[par * 4 + 1] = b63 + mu63; }
      }
      __syncthreads();
      if (w == 0 && cc + 1 < 36) {
        const int sg = (cc + 1) >= 4;
        const int pos = (sg ? cc + 1 - 4 : cc + 1) * 64 + lane;
        const int Ls = sg ? 2048 : 256;
        const int t = dir ? Ls - 1 - pos : pos;
        const int tok = (sg ? b * 2048 : NLAT + b * 256) + t;
        pgi = Zgt[(size_t)tok * 16 + (dir ? 8 : 0) + h];
        pgf = Zgt[(size_t)tok * 16 + (dir ? 12 : 4) + h];
      }
      const float dec = scA[par * 4];
      const float mnew = scA[par * 4 + 1];
#pragma unroll
      for (int i = 0; i < 9; i++) {
        const int u = tid + NTHR * i;
        const int which = i / 3;
        const int rem = u - which * 1536;
        const int tau = rem & 63;
        const int d8 = (rem >> 6) * 8;
        const int pos = c * 64 + tau;
        const int t = dir ? Lseg - 1 - pos : pos;
        const int tok = tokbase + t;
        if (which < 2) {
          const bfu* zp = Zml + (size_t)tok * 3072 + which * 768 + h * 192 + d8;
          const int tm = t & (RL - 1);
          const uint4 mid = *(const uint4*)zp;
          const uint4 lft = *(const uint4*)(zp - ((tm != 0) ? 3072 : 0));
          const uint4 rgt = *(const uint4*)(zp + ((tm != RL - 1) ? 3072 : 0));
          const float lvf = (tm != 0) ? 1.f : 0.f, rvf = (tm != RL - 1) ? 1.f : 0.f;
          const unsigned ml_[4] = {lft.x, lft.y, lft.z, lft.w};
          const unsigned mm_[4] = {mid.x, mid.y, mid.z, mid.w};
          const unsigned mr_[4] = {rgt.x, rgt.y, rgt.z, rgt.w};
          const float* cwx = cw + which * 192 + d8;
          float v[8];
#pragma unroll
          for (int e = 0; e < 8; e++) {
            const float a = (e & 1) ? hi16(ml_[e >> 1]) : lo16(ml_[e >> 1]);
            const float bm = (e & 1) ? hi16(mm_[e >> 1]) : lo16(mm_[e >> 1]);
            const float cr = (e & 1) ? hi16(mr_[e >> 1]) : lo16(mr_[e >> 1]);
            float s = cwx[e] * (a * lvf) + cwx[384 + e] * bm + cwx[768 + e] * (cr * rvf) + cwx[1152 + e];
            s = s / (1.f + __expf(-s));
            v[e] = s;
          }
          if (which == 0) {
            uint4 o;
            o.x = pack2(v[0], v[1]); o.y = pack2(v[2], v[3]); o.z = pack2(v[4], v[5]); o.w = pack2(v[6], v[7]);
            *(uint4*)(sq + tau * 200 + d8) = o;
          } else {
            const float wk = wkA[par * 64 + tau];
#pragma unroll
            for (int e = 0; e < 8; e++) v[e] *= 0.07216878364870323f;
            uint4 o;
            o.x = pack2(v[0], v[1]); o.y = pack2(v[2], v[3]); o.z = pack2(v[4], v[5]); o.w = pack2(v[6], v[7]);
            *(uint4*)(sk + tau * 200 + d8) = o;
#pragma unroll
            for (int e = 0; e < 8; e++) swk[(d8 + e) * 72 + tau] = f2bf(wk * v[e]);
          }
        } else {
          const bfu* zp = Zml + (size_t)tok * 3072 + 1536 + h * 192 + d8;
          const uint4 mid = *(const uint4*)zp;
          const unsigned mm_[4] = {mid.x, mid.y, mid.z, mid.w};
#pragma unroll
          for (int e = 0; e < 8; e++) svT[(d8 + e) * 72 + tau] = (bfu)((e & 1) ? (mm_[e >> 1] >> 16) : (mm_[e >> 1] & 0xffffu));
        }
      }
      __syncthreads();
      f32x16 num[2];
#pragma unroll
      for (int r = 0; r < 16; r++) { num[0][r] = 0.f; num[1][r] = 0.f; }
      if (w < 7) {
#pragma unroll
        for (int i = 0; i < 6; i++) {
#pragma unroll
          for (int s2 = 0; s2 < 2; s2++) {
            uint4 pk;
            pk.x = pack2(st[i][8 * s2 + 0], st[i][8 * s2 + 1]);
            pk.y = pack2(st[i][8 * s2 + 2], st[i][8 * s2 + 3]);
            pk.z = pack2(st[i][8 * s2 + 4], st[i][8 * s2 + 5]);
            pk.w = pack2(st[i][8 * s2 + 6], st[i][8 * s2 + 7]);
            const bf16x8 aop = u4_to_bf8(pk);
#pragma unroll
            for (int ti = 0; ti < 2; ti++) {
              const bfu* qp = sq + (ti * 32 + lr) * 200 + 32 * i + 16 * s2 + 4 * lh;
              const uint2 lo = *(const uint2*)qp;
              const uint2 hi = *(const uint2*)(qp + 8);
              const uint4 bq = make_uint4(lo.x, lo.y, hi.x, hi.y);
              num[ti] = mfma32(aop, u4_to_bf8(bq), num[ti]);
            }
          }
        }
#pragma unroll
        for (int ti = 0; ti < 2; ti++) {
          const float wi = winA[par * 64 + ti * 32 + lr];
#pragma unroll
          for (int r = 0; r < 16; r++) num[ti][r] *= wi;
        }
      }
      if (w < 4) {
        const int si = w >> 1, ti = w & 1;
        f32x16 acc;
#pragma unroll
        for (int r = 0; r < 16; r++) acc[r] = 0.f;
#pragma unroll
        for (int kk = 0; kk < 12; kk++) {
          const bf16x8 a = *(const bf16x8*)(sk + (si * 32 + lr) * 200 + kk * 16 + lh * 8);
          const bf16x8 bq = *(const bf16x8*)(sq + (ti * 32 + lr) * 200 + kk * 16 + lh * 8);
          acc = mfma32(a, bq, acc);
        }
        const int t = ti * 32 + lr;
        const float mut = muA[par * 64 + t];
#pragma unroll
        for (int g4 = 0; g4 < 4; g4++) {
          const int s0 = si * 32 + 8 * g4 + 4 * lh;
          float vv[4];
#pragma unroll
          for (int r4 = 0; r4 < 4; r4++) {
            const int s = s0 + r4;
            const float e = __expf(fminf(rA[par * 64 + s] - mut, 0.f));
            vv[r4] = (s <= t) ? acc[4 * g4 + r4] * e : 0.f;
          }
          uint2 o;
          o.x = pack2(vv[0], vv[1]); o.y = pack2(vv[2], vv[3]);
          *(uint2*)(sS + t * 72 + s0) = o;
        }
      }
      __syncthreads();
      if (w < 7) {
#pragma unroll
        for (int ti = 0; ti < 2; ti++) {
#pragma unroll
          for (int kk = 0; kk < 4; kk++) {
            const bf16x8 a = *(const bf16x8*)(svT + (32 * w + lr) * 72 + kk * 16 + lh * 8);
            const bf16x8 bs = *(const bf16x8*)(sS + (ti * 32 + lr) * 72 + kk * 16 + lh * 8);
            num[ti] = mfma32(a, bs, num[ti]);
          }
        }
        if (w == 6 && lh == 0) { denA[lr] = num[0][0]; denA[32 + lr] = num[1][0]; }
#pragma unroll
        for (int i = 0; i < 6; i++) {
#pragma unroll
          for (int r = 0; r < 16; r++) st[i][r] *= dec;
#pragma unroll
          for (int kk = 0; kk < 4; kk++) {
            const bf16x8 a = *(const bf16x8*)(swk + (32 * i + lr) * 72 + kk * 16 + lh * 8);
            const bf16x8 bv = *(const bf16x8*)(svT + (32 * w + lr) * 72 + kk * 16 + lh * 8);
            st[i] = mfma32(a, bv, st[i]);
          }
        }
      }
      __syncthreads();
      if (w < 6) {
#pragma unroll
        for (int ti = 0; ti < 2; ti++) {
          const int tl = ti * 32 + lr;
          const float dn = fmaxf(fabsf(denA[tl]), emtA[par * 64 + tl]);
          const float inv = 1.f / dn;
          const int pos = c * 64 + tl;
          const int t = dir ? Lseg - 1 - pos : pos;
          bfu* dst = H + (size_t)(tokbase + t) * 768 + h * 192 + 32 * w + 4 * lh;
#pragma unroll
          for (int g4 = 0; g4 < 4; g4++) {
            uint2 o;
            o.x = pack2(num[ti][4 * g4] * inv, num[ti][4 * g4 + 1] * inv);
            o.y = pack2(num[ti][4 * g4 + 2] * inv, num[ti][4 * g4 + 3] * inv);
            *(uint2*)(dst + 8 * g4) = o;
          }
        }
      }
      m = mnew;
    }
  }
}

DI void conv_taps(const PX& p, int l, int ch, float (&wt)[4]) {
  wt[0] = p.in[7][(l * 3 + 0) * 2304 + ch];
  wt[1] = p.in[7][(l * 3 + 1) * 2304 + ch];
  wt[2] = p.in[7][(l * 3 + 2) * 2304 + ch];
  wt[3] = p.in[8][l * 2304 + ch];
}
template <int L>
DI void hy_fill_copies(const PX& p, const bfu* __restrict__ Rg, bfu* cp) {
  constexpr int CSTR = 2 * L + 16;
  int tx = TIDX(p); OPAQUE(tx);
  bfu vv[(2 * L + NTHR - 1) / NTHR];
#pragma unroll
  for (int i = 0; i < (2 * L + NTHR - 1) / NTHR; i++) { const int x = tx + i * NTHR; vv[i] = (x < 2 * L) ? Rg[x < 2 * L ? x : 0] : (bfu)0; }
#pragma unroll
  for (int i = 0; i < (2 * L + NTHR - 1) / NTHR; i++) {
    const int x = tx + i * NTHR;
    if (x < 2 * L) {
      const bfu v = (x == 0) ? (bfu)0 : vv[i];
#pragma unroll
      for (int e = 0; e < 8; e++) cp[e * CSTR + x + e] = v;
    }
  }
}
template <int L, int TPW>
DI void hy_mfma(const PX& p, f32x4 (&acc)[TPW], const bfu* cp, const bfu* U) {
  constexpr int CSTR = 2 * L + 16, USTR = L + 8, NS = L / 32;
  int tx = TIDX(p); OPAQUE(tx);
  const int lane = tx & 63, w = tx >> 6;
  const int i = lane & 15, kq = lane >> 4, e = i & 7, ih = i >> 3;
  const bfu* cpe = cp + e * CSTR;
  const bfu* Ub = U + i * USTR + 8 * kq;
#pragma unroll
  for (int m = 0; m < TPW; m++) acc[m] = f32x4{0.f, 0.f, 0.f, 0.f};
  const int qb0 = L / 8 + kq - ih - 2 * (w * TPW);
  if constexpr (TPW == 16) {
    bf16x8 F[16];
#pragma unroll
    for (int m = 0; m < 16; m++) F[m] = *(const bf16x8*)(cpe + 8 * (qb0 - 2 * m));
#pragma unroll 1
    for (int k = 0; k < NS / 8; k++) {
#pragma unroll
      for (int j = 0; j < 8; j++) {
        const int ss = 8 * k + j;
        const int qb = qb0 + 4 * ss;
        F[(0 - 2 * j) & 15] = *(const bf16x8*)(cpe + 8 * qb);
        F[(1 - 2 * j) & 15] = *(const bf16x8*)(cpe + 8 * (qb - 2));
        const bf16x8 bfr = *(const bf16x8*)(Ub + 32 * ss);
#pragma unroll
        for (int m = 0; m < 16; m++) acc[m] = mfma16(F[(m - 2 * j) & 15], bfr, acc[m]);
      }
    }
  } else {
#pragma unroll 1
    for (int ss = 0; ss < NS; ss++) {
      const bf16x8 bfr = *(const bf16x8*)(Ub + 32 * ss);
      const int qb = qb0 + 4 * ss;
#pragma unroll
      for (int m = 0; m < TPW; m++) {
        const bf16x8 afr = *(const bf16x8*)(cpe + 8 * (qb - 2 * m));
        acc[m] = mfma16(afr, bfr, acc[m]);
      }
    }
  }
}
template <int L>
DI void hyena_job(const PX& p, int l, int c, unsigned char* smem) {
  constexpr int CSTR = 2 * L + 16, USTR = L + 8, TPW = L / 128, RL = (L == 2048) ? 64 : 256;
  int tid_ = TIDX(p); OPAQUE(tid_); const int tid = tid_, lane = tid & 63, w = tid >> 6;
  bfu* cp = (bfu*)smem;
  bfu* U = cp + 8 * CSTR;
  const int tokbase = (L == 2048) ? 0 : NLAT;
  const bfu* Rg = (const bfu*)(p.ws + OFF_FILT + ((L == 2048) ? (size_t)l * FILT_L : 2 * FILT_L)) + (size_t)c * (2 * L);
  const bfu* Zhy = wsb(p, OFF_BIG + B_ZHY);
  const bfu* zv = Zhy + (size_t)c * NTOK + tokbase;
  const bfu* zx1 = Zhy + (size_t)(768 + c) * NTOK + tokbase;
  const bfu* zx2 = Zhy + (size_t)(1536 + c) * NTOK + tokbase;
  float wv[4], w1[4], w2[4];
  conv_taps(p, l, c, wv);
  conv_taps(p, l, 768 + c, w1);
  conv_taps(p, l, 1536 + c, w2);
  const float bias0 = p.in[16][(l * 2 + 0) * 768 + c];
  const float bias1 = p.in[16][(l * 2 + 1) * 768 + c];
  __syncthreads();
  hy_fill_copies<L>(p, Rg, cp);
#pragma unroll
  for (int ui = 0; ui < (16 * (L / 8)) / NTHR; ui++) {
    const int u = tid + ui * NTHR;
    const int b = u / (L / 8), s8 = (u % (L / 8)) * 8;
    const bfu* zr = zv + b * L;
    const uint4 mid = *(const uint4*)(zr + s8);
    const bool lv = (s8 % RL != 0), rv = ((s8 + 8) % RL != 0);
    const float lft = bf2f(zr[lv ? s8 - 1 : s8]) * (lv ? 1.f : 0.f);
    const float rgt = bf2f(zr[rv ? s8 + 8 : s8]) * (rv ? 1.f : 0.f);
    float z[10];
    z[0] = lft; z[9] = rgt;
    z[1] = lo16(mid.x); z[2] = hi16(mid.x); z[3] = lo16(mid.y); z[4] = hi16(mid.y);
    z[5] = lo16(mid.z); z[6] = hi16(mid.z); z[7] = lo16(mid.w); z[8] = hi16(mid.w);
    float o[8];
#pragma unroll
    for (int e = 0; e < 8; e++) o[e] = wv[0] * z[e] + wv[1] * z[e + 1] + wv[2] * z[e + 2] + wv[3];
    uint4 pk;
    pk.x = pack2(o[0], o[1]); pk.y = pack2(o[2], o[3]); pk.z = pack2(o[4], o[5]); pk.w = pack2(o[6], o[7]);
    *(uint4*)(U + b * USTR + s8) = pk;
  }
  __syncthreads();
  const int b = lane & 15, kq = lane >> 4;
  uint2 y1pk[TPW];
  {
    f32x4 acc[TPW];
    hy_mfma<L, TPW>(p, acc, cp, U);
    int kq_o = kq;
    OPAQUE(kq_o);
#pragma unroll
    for (int m = 0; m < TPW; m++) {
      const int t0 = 16 * (w * TPW + m) + 4 * kq_o;
      const bfu* zr = zx1 + b * L;
      const uint2 mid = *(const uint2*)(zr + t0);
      const bool lv = (t0 % RL != 0), rv = ((t0 + 4) % RL != 0);
      const float lft = bf2f(zr[lv ? t0 - 1 : t0]) * (lv ? 1.f : 0.f);
      const float rgt = bf2f(zr[rv ? t0 + 4 : t0]) * (rv ? 1.f : 0.f);
      float z[6];
      z[0] = lft; z[5] = rgt; z[1] = lo16(mid.x); z[2] = hi16(mid.x); z[3] = lo16(mid.y); z[4] = hi16(mid.y);
      const uint2 vu = *(const uint2*)(U + b * USTR + t0);
      const float vv[4] = {lo16(vu.x), hi16(vu.x), lo16(vu.y), hi16(vu.y)};
      float y[4];
#pragma unroll
      for (int r = 0; r < 4; r++) {
        const float x1 = w1[0] * z[r] + w1[1] * z[r + 1] + w1[2] * z[r + 2] + w1[3];
        y[r] = x1 * (acc[m][r] + bias0 * vv[r]);
      }
      y1pk[m].x = pack2(y[0], y[1]);
      y1pk[m].y = pack2(y[2], y[3]);
    }
  }
  __syncthreads();
#pragma unroll
  for (int m = 0; m < TPW; m++) *(uint2*)(U + b * USTR + 16 * (w * TPW + m) + 4 * kq) = y1pk[m];
  hy_fill_copies<L>(p, Rg + (size_t)768 * (2 * L), cp);
  __syncthreads();
  {
    f32x4 acc[TPW];
    hy_mfma<L, TPW>(p, acc, cp, U);
    bfu* yrow = (bfu*)zv;
    int kq_o = kq;
    OPAQUE(kq_o);
#pragma unroll
    for (int m = 0; m < TPW; m++) {
      const int t0 = 16 * (w * TPW + m) + 4 * kq_o;
      const bfu* zr = zx2 + b * L;
      const uint2 mid = *(const uint2*)(zr + t0);
      const bool lv = (t0 % RL != 0), rv = ((t0 + 4) % RL != 0);
      const float lft = bf2f(zr[lv ? t0 - 1 : t0]) * (lv ? 1.f : 0.f);
      const float rgt = bf2f(zr[rv ? t0 + 4 : t0]) * (rv ? 1.f : 0.f);
      float z[6];
      z[0] = lft; z[5] = rgt; z[1] = lo16(mid.x); z[2] = hi16(mid.x); z[3] = lo16(mid.y); z[4] = hi16(mid.y);
      const uint2 vu = *(const uint2*)(U + b * USTR + t0);
      const float vv[4] = {lo16(vu.x), hi16(vu.x), lo16(vu.y), hi16(vu.y)};
      float y2[4];
#pragma unroll
      for (int r = 0; r < 4; r++) {
        const float x2 = w2[0] * z[r] + w2[1] * z[r + 1] + w2[2] * z[r + 2] + w2[3];
        y2[r] = x2 * (acc[m][r] + bias1 * vv[r]);
      }
      uint2 o2; o2.x = pack2(y2[0], y2[1]); o2.y = pack2(y2[2], y2[3]);
      *(uint2*)(yrow + b * L + t0) = o2;
    }
  }
}

DI void branch_phase(const PX& p, int l, int slot, unsigned char* smem, int mode = 3) {
  __shared__ int sjob;
  if (mode & 1)
  for (int jb = blockIdx.x; jb < 176; jb += gridDim.x) {
    if (jb < 48) { if (EN & 16) s5_job(p, l, jb, smem); }
    else { if (EN & 32) mlstm_job(p, l, jb - 48, smem); }
  }
  unsigned* cnt = (unsigned*)(p.ws + OFF_CNT) + slot;
  const int nj = (mode & 2) ? ((l == 0) ? 1536 : 768) : 0;
  while (true) {
    __syncthreads();
    if (TIDX(p) == 0) sjob = (int)atomicAdd(cnt, 1u);
    __syncthreads();
    const int j = sjob;
    if (j >= nj) break;
    if (j < 768) { if (EN & 64) hyena_job<2048>(p, l, j, smem); }
    else { if (EN & 128) hyena_job<256>(p, l, j - 768, smem); }
  }
}

DI void gbar(const PX& p, unsigned target) {
  asm volatile("s_waitcnt vmcnt(0)" ::: "memory");
  __syncthreads();
  if (TIDX(p) == 0) {
    unsigned* cnt = (unsigned*)(p.ws + OFF_CNT) + 32;
    __builtin_amdgcn_fence(__ATOMIC_RELEASE, "agent");
    asm volatile("s_waitcnt vmcnt(0)" ::: "memory");
    __hip_atomic_fetch_add(cnt, 1u, __ATOMIC_RELAXED, __HIP_MEMORY_SCOPE_AGENT);
    unsigned spins = 0;
    while (__hip_atomic_load(cnt, __ATOMIC_RELAXED, __HIP_MEMORY_SCOPE_AGENT) < target) {
      __builtin_amdgcn_s_sleep(2);
      if (++spins > (1u << 26)) break;
    }
    __builtin_amdgcn_fence(__ATOMIC_ACQUIRE, "agent");
    asm volatile("s_waitcnt vmcnt(0)" ::: "memory");
  }
  __syncthreads();
}
#define NPHASE 23
#define SMEM_BYTES 135168
__global__ void __launch_bounds__(NTHR) mega(P p0, int ph_lo, int ph_hi) {
  PX p;
  *(P*)&p = p0;
  p.wv = __builtin_amdgcn_readfirstlane((int)(threadIdx.x >> 6));
  __shared__ __attribute__((aligned(16))) unsigned char smem[SMEM_BYTES];
  cg::grid_group grid = cg::this_grid();
  for (int ph = ph_lo; ph < ph_hi; ph++) {
    if (ph == 0) { if (EN & 1) phase0(p, smem); if (REP0) { grid.sync(); phase0(p, smem); } }
    else if (ph == 1) { phase1(p); if (REP0) { grid.sync(); phase1(p); } }
    else if (ph == 2) { phase2(p); if (REP0) { grid.sync(); phase2(p); } }
    else {
      const int l = (ph - 3) / 10, i = (ph - 3) % 10;
      const int nrep = (((REP >> i) & 1) && (i != 5 || l == 0)) ? 2 : 1;
      for (int rp = 0; rp < nrep; rp++) {
      if (rp) grid.sync();
      const int M = (l == 0) ? NTOK : NLAT;
      const bfu* W1 = wsb(p, OFF_W1);
      const bfu* W2 = wsb(p, OFF_BIG + B_W2);
      if (i == 0) {
        if (EN & 2) gemm_phase<EPI_INPROJ>(p, l, wsb(p, OFF_H), W1 + W1_WIN, 2048, NTOK, 24, 0, false, smem);
        if (gridDim.x > 128) { if (blockIdx.x >= 128) gate_gemm(p, blockIdx.x - 128, gridDim.x - 128); }
        else gate_gemm(p, blockIdx.x, gridDim.x);
      }
      else if (i == 1) {
        if (EN & 4) branch_phase(p, l, l + 2 * rp, smem);
#if PAIR
        grid.sync();
        gemm_phase<EPI_INPROJ>(p, l, wsb(p, OFF_H), W1 + W1_WIN, 2048, NTOK, 25, 0, false, smem);
        grid.sync();
        branch_phase(p, l, l + 4, smem, PAIR);
#endif
      }
      else if (i == 2) post_scan(p, l, M, smem);
      else if (i == 3) gemm_phase<EPI_GLU>(p, l, wsb(p, OFF_BIG + B_YF), W1 + W1_GLU, 768, M, 3, 0, false, smem);
      else if (i == 4) { if (EN & 8) merge_phase(p, NLAT, smem, M - NLAT); }
      else if (i == 5) gemm_phase<EPI_RES>(p, l, wsb(p, OFF_BIG + B_ZHY), W1 + W1_WOUT, 2048, NLAT, 8, 2, l == 0, smem, M - NLAT);
      else if (i == 6) {
        ln_pass(p, l, 0, M);
        const int total = FFN_TILES + ((l == 0) ? MIX_TILES : 0);
        for (int rc = 0; rc < 1 + REPC; rc++)
        for (int it = blockIdx.x; it < total; it += gridDim.x) {
          if (it < FFN_TILES) convert_ffn(p, l, it, (float*)smem);
          else convert_mixer(p, l + 1, it - FFN_TILES, (float*)smem);
        }
      }
      else if (i == 7) gemm_phase<EPI_FF1>(p, l, wsb(p, OFF_H), W2, 2048, M, 32, 0, false, smem);
      else if (i == 8) gemm_phase<EPI_RES>(p, l, wsb(p, OFF_BIG), W2 + (size_t)8192 * 2048, 8192, NLAT, 8, 5, false, smem, M - NLAT);
      else ln_pass(p, l, 1, M);
      }
    }
    if (ph + 1 < ph_hi) {
      if (ph == ph_lo) grid.sync();
      else gbar(p, (unsigned)(ph - ph_lo) * gridDim.x);
    }
  }
}

#ifndef SINGLE_LAUNCH
#define SINGLE_LAUNCH 1
#endif

extern "C" void kernel_launch(void* const* d_in, const int* in_sizes, int n_in, void* d_out, int out_size, void* d_ws,
                              size_t ws_size, hipStream_t stream) {
  P p;
  memset(&p, 0, sizeof(p));
  for (int i = 0; i < 41; i++) p.in[i] = (const float*)d_in[i];
  p.out = (float*)d_out;
  p.ws = (unsigned char*)d_ws;
  if (ws_size < WS_NEED) { fprintf(stderr, "workspace too small: %zu < %zu\n", ws_size, WS_NEED); return; }
#if SINGLE_LAUNCH
  static int grid_blocks = 0;
  if (!grid_blocks) {
    int dev = 0, cus = 0, per_cu = 0;
    hipGetDevice(&dev);
    hipDeviceGetAttribute(&cus, hipDeviceAttributeMultiprocessorCount, dev);
    hipOccupancyMaxActiveBlocksPerMultiprocessor(&per_cu, mega, NTHR, 0);
    if (per_cu < 1) per_cu = 1;
    if (per_cu > 1) per_cu = 1;
    grid_blocks = cus * per_cu;
  }
  int lo = 0, hi = NPHASE;
  void* args[] = {&p, &lo, &hi};
  hipError_t e = hipLaunchCooperativeKernel((void*)mega, dim3(grid_blocks), dim3(NTHR), args, 0, stream);
  if (e != hipSuccess) fprintf(stderr, "cooperative launch failed: %s (grid %d)\n", hipGetErrorString(e), grid_blocks);
#else
  for (int ph = 0; ph < NPHASE; ph++) mega<<<dim3(256), dim3(NTHR), 0, stream>>>(p, ph, ph + 1);
#endif
}
```
